# Optimizing an MI355X kernel written in HIP

```python
import jax, jax.numpy as jnp
from jax import lax
import numpy as np

D_MODEL = 1024
BATCH = 16
SEQ = 2048
DEPTH = 4

CHUNK = 64
N_MIXERS = 3
EPS = 1e-6

GMLP_BLOCK = 128
A_WIDTH = D_MODEL
A_GROUPS = 8
A_GROUP_DIM = A_WIDTH // A_GROUPS

B_WIDTH = D_MODEL
CONV_WIDTH = 3

C_WIDTH = D_MODEL
POOL_WINDOWS = (2, 4, 8, 16)
C_GROUPS = len(POOL_WINDOWS)
C_GROUP_DIM = C_WIDTH // C_GROUPS

FFN_HIDDEN = ((8 * D_MODEL + 3 * 256 - 1) // (3 * 256)) * 256

N_A = (DEPTH + 2) // 3
N_B = (DEPTH + 1) // 3
N_C = DEPTH // 3

kernel_name = "interleaved_gmlp_shortconv_pool_trunk"


def _rms_norm(x, g):
    x32 = x.astype(jnp.float32)
    y = x32 * lax.rsqrt(jnp.mean(x32 * x32, axis=-1, keepdims=True) + EPS)
    return (y * g.astype(jnp.float32)).astype(x.dtype)


def _chunk_causal_mask(n):
    pos = jnp.arange(n)
    return (pos[None, :] // CHUNK) <= (pos[:, None] // CHUNK)


def _spatial_gating_mixer(h, w_in, v_norm_g, w_s, b_s, w_out):
    b, s, _ = h.shape
    z = jax.nn.gelu(h @ w_in, approximate=False)
    u, v = jnp.split(z, 2, axis=-1)
    v32 = v.astype(jnp.float32)
    mu = jnp.mean(v32, axis=-1, keepdims=True)
    var = jnp.mean(jnp.square(v32 - mu), axis=-1, keepdims=True)
    v = ((v32 - mu) * lax.rsqrt(var + EPS) * v_norm_g.astype(jnp.float32)).astype(h.dtype)
    v = v.reshape(b, s // GMLP_BLOCK, GMLP_BLOCK, A_GROUPS, A_GROUP_DIM)
    w_masked = jnp.where(_chunk_causal_mask(GMLP_BLOCK)[None], w_s, 0)
    sv = jnp.einsum('gij,bnjgc->bnigc', w_masked, v) + b_s.T[None, None, :, :, None]
    y = u * sv.reshape(b, s, A_WIDTH)
    return y @ w_out


def _causal_depthwise_conv(x, conv_w):
    return lax.conv_general_dilated(
        x, conv_w[:, None, :],
        window_strides=(1,),
        padding=[(CONV_WIDTH - 1, 0)],
        dimension_numbers=('NWC', 'WIO', 'NWC'),
        feature_group_count=x.shape[-1])


def _short_conv_mixer(h, w_in, conv_w, w_out):
    gate_b, gate_c, xt = jnp.split(h @ w_in, 3, axis=-1)
    y = _causal_depthwise_conv(gate_c * xt, conv_w)
    return (gate_b * y) @ w_out


def _multiscale_pool_mixer(h, w_in, w_grp, scale, w_out):
    b, s, _ = h.shape
    p = (h @ w_in).reshape(b, s, C_GROUPS, C_GROUP_DIM)
    p32 = p.astype(jnp.float32)
    cs = jnp.cumsum(p32, axis=1)
    t = jnp.arange(1, s + 1, dtype=jnp.float32)
    outs = []
    for g, w in enumerate(POOL_WINDOWS):
        csg = cs[:, :, g]
        shifted = jnp.pad(csg[:, :s - w], ((0, 0), (w, 0), (0, 0)))
        mean = (csg - shifted) / jnp.minimum(t, w)[None, :, None]
        outs.append(mean - p32[:, :, g])
    d = jnp.stack(outs, axis=2).astype(h.dtype)
    y = jnp.einsum('bsgc,gcd->bsgd', d, w_grp).reshape(b, s, C_WIDTH) * scale
    return y @ w_out


def _swiglu(h, w_gate, w_up, w_down):
    return (jax.nn.silu(h @ w_gate) * (h @ w_up)) @ w_down


def setup_inputs(seed: int = 0) -> dict:
    key = jax.random.key(seed)
    ks = jax.random.split(key, 24)
    f32 = jnp.float32

    def nrm(k, shape, scale):
        return jax.random.normal(k, shape, f32) * scale

    x = jax.random.normal(ks[0], (BATCH, SEQ, D_MODEL), f32)
    norm_mix_g = 1.0 + nrm(ks[1], (DEPTH, D_MODEL), 0.05)
    norm_ffn_g = 1.0 + nrm(ks[2], (DEPTH, D_MODEL), 0.05)
    final_norm_g = 1.0 + nrm(ks[3], (D_MODEL,), 0.05)

    a_w_in = nrm(ks[4], (N_A, D_MODEL, 2 * A_WIDTH), D_MODEL ** -0.5)
    a_v_norm_g = 1.0 + nrm(ks[5], (N_A, A_WIDTH), 0.05)
    a_w_s = nrm(ks[6], (N_A, A_GROUPS, GMLP_BLOCK, GMLP_BLOCK), GMLP_BLOCK ** -0.5)
    a_b_s = 1.0 + nrm(ks[7], (N_A, A_GROUPS, GMLP_BLOCK), 0.05)
    a_w_out = nrm(ks[8], (N_A, A_WIDTH, D_MODEL), A_WIDTH ** -0.5)

    b_w_in = nrm(ks[9], (N_B, D_MODEL, 3 * B_WIDTH), D_MODEL ** -0.5)
    b_conv_w = nrm(ks[10], (N_B, CONV_WIDTH, B_WIDTH), CONV_WIDTH ** -0.5)
    b_w_out = nrm(ks[11], (N_B, B_WIDTH, D_MODEL), B_WIDTH ** -0.5)

    c_w_in = nrm(ks[12], (N_C, D_MODEL, C_WIDTH), D_MODEL ** -0.5)
    c_w_grp = nrm(ks[13], (N_C, C_GROUPS, C_GROUP_DIM, C_GROUP_DIM), C_GROUP_DIM ** -0.5)
    c_scale = 1.0 + nrm(ks[14], (N_C, C_WIDTH), 0.1)
    c_w_out = nrm(ks[15], (N_C, C_WIDTH, D_MODEL), C_WIDTH ** -0.5)

    f_w_gate = nrm(ks[16], (DEPTH, D_MODEL, FFN_HIDDEN), D_MODEL ** -0.5)
    f_w_up = nrm(ks[17], (DEPTH, D_MODEL, FFN_HIDDEN), D_MODEL ** -0.5)
    f_w_down = nrm(ks[18], (DEPTH, FFN_HIDDEN, D_MODEL), FFN_HIDDEN ** -0.5)

    return {
        "x": x,
        "norm_mix_g": norm_mix_g, "norm_ffn_g": norm_ffn_g, "final_norm_g": final_norm_g,
        "a_w_in": a_w_in, "a_v_norm_g": a_v_norm_g, "a_w_s": a_w_s, "a_b_s": a_b_s,
        "a_w_out": a_w_out,
        "b_w_in": b_w_in, "b_conv_w": b_conv_w, "b_w_out": b_w_out,
        "c_w_in": c_w_in, "c_w_grp": c_w_grp, "c_scale": c_scale, "c_w_out": c_w_out,
        "f_w_gate": f_w_gate, "f_w_up": f_w_up, "f_w_down": f_w_down,
    }


def reference(x, norm_mix_g, norm_ffn_g, final_norm_g,
              a_w_in, a_v_norm_g, a_w_s, a_b_s, a_w_out,
              b_w_in, b_conv_w, b_w_out,
              c_w_in, c_w_grp, c_scale, c_w_out,
              f_w_gate, f_w_up, f_w_down):
    for i in range(DEPTH):
        kind = i % N_MIXERS
        j = i // N_MIXERS
        h = _rms_norm(x, norm_mix_g[i])
        if kind == 0:
            m = _spatial_gating_mixer(h, a_w_in[j], a_v_norm_g[j], a_w_s[j], a_b_s[j], a_w_out[j])
        elif kind == 1:
            m = _short_conv_mixer(h, b_w_in[j], b_conv_w[j], b_w_out[j])
        else:
            m = _multiscale_pool_mixer(h, c_w_in[j], c_w_grp[j], c_scale[j], c_w_out[j])
        x = x + m
        h = _rms_norm(x, norm_ffn_g[i])
        x = x + _swiglu(h, f_w_gate[i], f_w_up[i], f_w_down[i])
    return _rms_norm(x, final_norm_g)
```

```cpp
#include <hip/hip_runtime.h>
#include <hip/hip_cooperative_groups.h>
#include <cstdio>
#include <cstdint>
namespace cg = cooperative_groups;

#define LAS __attribute__((address_space(3)))
typedef unsigned short bf16_t;
typedef short bf16x8 __attribute__((ext_vector_type(8)));
typedef float f32x4 __attribute__((ext_vector_type(4)));
typedef float f32x2 __attribute__((ext_vector_type(2)));
typedef unsigned u32x4 __attribute__((ext_vector_type(4)));
typedef unsigned u32x2 __attribute__((ext_vector_type(2)));

constexpr int D = 1024, BATCH = 16, SEQ = 2048, M = BATCH * SEQ, FH = 2816, DEPTH = 4;
constexpr float EPS = 1e-6f;
constexpr int NWAVES = 8, NTHR = 512;

constexpr size_t MiB = 1u << 20;
constexpr size_t WS_W = 4 * MiB;
constexpr size_t WS_XB = 96 * MiB;
constexpr size_t WS_H = 160 * MiB;
constexpr size_t WS_T1 = WS_H;
constexpr size_t WS_T2 = 336 * MiB;
constexpr size_t WS_CTL = 400 * MiB;
constexpr size_t WS_VST = WS_CTL + 5 * MiB;
constexpr size_t WS_BAR = WS_CTL + 7 * MiB, BAR_BYTES = 32768;
constexpr size_t WS_END = 408 * MiB;
constexpr size_t Mi = 1u << 20;
constexpr size_t WO_A_IN0 = 0, WO_A_OUT0 = WO_A_IN0 + 2 * Mi, WO_A_S0 = WO_A_OUT0 + Mi, WO_A_STRIDE = 3 * Mi + 128 * 1024;
constexpr size_t WO_B_CX = 2 * WO_A_STRIDE, WO_B_B = WO_B_CX + 2 * Mi, WO_B_OUT = WO_B_B + Mi;
constexpr size_t WO_C_IN = WO_B_OUT + Mi, WO_C_GRP = WO_C_IN + Mi, WO_C_OUT = WO_C_GRP + 256 * 1024;
constexpr size_t WO_F_GU0 = WO_C_OUT + Mi, WO_F_D0 = WO_F_GU0 + (size_t)2 * FH * D, WO_F_STRIDE = (size_t)3 * FH * D;
constexpr size_t WO_END = WO_F_GU0 + 4 * WO_F_STRIDE;
static_assert(WO_END * 2 <= WS_XB - WS_W, "weights fit");
static_assert(WS_H + (size_t)M * FH * 2 <= WS_T2, "H fits");

constexpr unsigned CHUNK_ADJ = 4u << 20;
constexpr int LDS_BYTES = 147456;

__device__ __forceinline__ float bflo(unsigned w) { return __builtin_bit_cast(float, w << 16); }
__device__ __forceinline__ float bfhi(unsigned w) { return __builtin_bit_cast(float, w & 0xffff0000u); }

namespace pg8 {
constexpr int BM = 256, BK = 64, HALF = 128, HTB = HALF * BK * 2, STAGE_BYTES = 8 * HTB, NXCD = 8, WGM = 8;
__host__ __device__ __forceinline__ int lds_byte(int r, int c) { const int st = (r >> 4) * 2 + (c >> 5), rr = r & 15, cc = c & 31, ob = rr * 64 + cc * 2; return st * 1024 + (ob ^ (((ob >> 9) & 1) << 5)); }
__host__ __device__ __forceinline__ void stage_rc(int b, int& R, int& C) { const int st = b / 1024, sb = b % 1024, swz = sb ^ (((sb >> 9) & 1) << 5); R = (st >> 1) * 16 + swz / 64; C = (st & 1) * 32 + (swz % 64) / 2; }
__host__ __device__ __forceinline__ int perm32(int rho) { const int n = rho >> 4, i = rho & 15; return 8 * (i >> 2) + 4 * n + (i & 3); }

struct Unit { int pm, pn; };
struct Gemm { const bf16_t* A; const bf16_t* Bt; int M, N, K, lda, a_pn_off; unsigned a_adj; };

struct StaticOrder {
    int nM, nN, nwg, G, c;
    __device__ void init(int M_, int N_, int G_, int c_) { nM = M_ / BM; nN = N_ / BM; nwg = nM * nN; G = G_; c = c_; }
    __device__ bool next(int i, Unit& u) const {
        const long L = (long)i * G + c; if (L >= nwg) return false;
        int wgid = (int)L; { const int q = nwg / NXCD, r = nwg % NXCD, xcd = wgid % NXCD, off = wgid / NXCD; wgid = (xcd < r ? xcd * (q + 1) : r * (q + 1) + (xcd - r) * q) + off; }
        const int nig = WGM * nN, gid = wgid / nig, fm = gid * WGM, gsz = (nM - fm) < WGM ? (nM - fm) : WGM;
        u.pm = fm + ((wgid % nig) % gsz); u.pn = (wgid % nig) / gsz; return true;
    }
};

__device__ __forceinline__ unsigned cvt_pk_bf16(float lo, float hi) { unsigned r; asm volatile("v_cvt_pk_bf16_f32 %0, %1, %2" : "=v"(r) : "v"(lo), "v"(hi)); return r; }
__device__ __forceinline__ f32x2 gelu_pk(f32x2 v) {
    const f32x2 av = __builtin_elementwise_abs(v), d = av * 0.2316418882f + 1.0f;
    f32x2 t; t.x = __builtin_amdgcn_rcpf(d.x); t.y = __builtin_amdgcn_rcpf(d.y);
    f32x2 q = t * 0.5307027145f + (-0.7265760135f); q = q * t + 0.7107068705f; q = q * t + (-0.142248368f); q = q * t + 0.127414796f; q = q * t;
    const f32x2 s = (v * v) * (-0.72134752044f);
    f32x2 e; e.x = __builtin_amdgcn_exp2f(s.x); e.y = __builtin_amdgcn_exp2f(s.y);
    const f32x2 m = v * (q * e), r = v - m;
    f32x2 o; o.x = v.x < 0.f ? m.x : r.x; o.y = v.y < 0.f ? m.y : r.y; return o;
}
__device__ __forceinline__ float rstd_of(const float* ss, int row) { const f32x4 p = *(const f32x4*)(ss + 4 * (size_t)row); return __builtin_amdgcn_rsqf(((p.x + p.y) + (p.z + p.w)) * (1.0f / D) + EPS); }
constexpr int PART_OFF = 131072 + 2048;
__device__ __forceinline__ float silu_f(float g) { return g * __builtin_amdgcn_rcpf(1.0f + __builtin_amdgcn_exp2f(g * -1.4426950408889634f)); }

__device__ __forceinline__ void rstd8(const float* ss, int row0, float (&rs)[2][4]) {
    f32x4 p[2][4];
#pragma unroll
    for (int ai = 0; ai < 2; ++ai)
#pragma unroll
        for (int m = 0; m < 4; ++m) p[ai][m] = *(const f32x4*)(ss + 4 * (size_t)(row0 + ai * HALF + m * 16));
#pragma unroll
    for (int ai = 0; ai < 2; ++ai)
#pragma unroll
        for (int m = 0; m < 4; ++m) rs[ai][m] = __builtin_amdgcn_rsqf(((p[ai][m].x + p[ai][m].y) + (p[ai][m].z + p[ai][m].w)) * (1.0f / D) + EPS);
}


struct EpiPlain {
    static constexpr bool DEFER = false;
    bf16_t* O; int ldc; const float* ss; const float* cscale; unsigned adj;
    __device__ __forceinline__ void operator()(const f32x4 (&acc)[2][2][4][2], const Unit& u, int wr, int wc, int fr, int fq) const {
        const int row0 = u.pm * BM + wr * 64 + fr, col0 = u.pn * BM + wc * 32 + 8 * fq;
        f32x4 cv[2][2];
#pragma unroll
        for (int bj = 0; bj < 2; ++bj)
#pragma unroll
            for (int n = 0; n < 2; ++n) cv[bj][n] = cscale ? *(const f32x4*)(cscale + col0 + bj * HALF + 4 * n) : (f32x4){1.f, 1.f, 1.f, 1.f};
        float rsv[2][4];
        if (ss) rstd8(ss, row0, rsv); else {
#pragma unroll
            for (int i = 0; i < 8; ++i) rsv[i >> 2][i & 3] = 1.0f; }
#pragma unroll
        for (int ai = 0; ai < 2; ++ai)
#pragma unroll
            for (int m = 0; m < 4; ++m) { const int row = row0 + ai * HALF + m * 16; const float rs = rsv[ai][m]; bf16_t* rowp = O + (size_t)row * ldc + col0 + (size_t)(row >> 12) * adj;
#pragma unroll
                for (int bj = 0; bj < 2; ++bj) { const f32x4 v0 = acc[ai][bj][m][0] * cv[bj][0] * rs, v1 = acc[ai][bj][m][1] * cv[bj][1] * rs;
                    u32x4 w; w.x = cvt_pk_bf16(v0[0], v0[1]); w.y = cvt_pk_bf16(v0[2], v0[3]); w.z = cvt_pk_bf16(v1[0], v1[1]); w.w = cvt_pk_bf16(v1[2], v1[3]);
                    *(u32x4*)(rowp + bj * HALF) = w; } }
    }
};
struct EpiGeluStats {
    static constexpr bool DEFER = false;
    bf16_t* O; int ldc; const float* ss; float* vstat; LAS unsigned char* lds;
    __device__ __forceinline__ void operator()(const f32x4 (&acc)[2][2][4][2], const Unit& u, int wr, int wc, int fr, int fq) const {
        const int row0 = u.pm * BM + wr * 64 + fr, col0 = u.pn * BM + wc * 32 + 8 * fq; const bool isv = u.pn >= 4;
        LAS float* part = (LAS float*)(lds + PART_OFF);
        float rsv[2][4]; rstd8(ss, row0, rsv);
#pragma unroll
        for (int ai = 0; ai < 2; ++ai)
#pragma unroll
            for (int m = 0; m < 4; ++m) { const int row = row0 + ai * HALF + m * 16; const float rs = rsv[ai][m]; bf16_t* rowp = O + (size_t)row * ldc + col0; float s1 = 0.f, s2 = 0.f;
#pragma unroll
                for (int bj = 0; bj < 2; ++bj) { f32x4 v0 = acc[ai][bj][m][0] * rs, v1 = acc[ai][bj][m][1] * rs;
                    const f32x2 a = gelu_pk((f32x2){v0[0], v0[1]}), b = gelu_pk((f32x2){v0[2], v0[3]}), c = gelu_pk((f32x2){v1[0], v1[1]}), d = gelu_pk((f32x2){v1[2], v1[3]});
                    s1 += ((a.x + a.y) + (b.x + b.y)) + ((c.x + c.y) + (d.x + d.y));
                    s2 += ((a.x * a.x + a.y * a.y) + (b.x * b.x + b.y * b.y)) + ((c.x * c.x + c.y * c.y) + (d.x * d.x + d.y * d.y));
                    u32x4 w; w.x = cvt_pk_bf16(a.x, a.y); w.y = cvt_pk_bf16(b.x, b.y); w.z = cvt_pk_bf16(c.x, c.y); w.w = cvt_pk_bf16(d.x, d.y);
                    *(u32x4*)(rowp + bj * HALF) = w; }
                if (isv) { s1 += __shfl_xor(s1, 16); s1 += __shfl_xor(s1, 32); s2 += __shfl_xor(s2, 16); s2 += __shfl_xor(s2, 32);
                    if (fq == 0) { const int rl = ai * HALF + wr * 64 + m * 16 + fr; part[rl * 4 + wc] = s1; part[1024 + rl * 4 + wc] = s2; } } }
        if (isv) {
            asm volatile("s_waitcnt lgkmcnt(0)" ::: "memory"); __builtin_amdgcn_s_barrier(); asm volatile("" ::: "memory");
            int t = threadIdx.x; asm volatile("" : "+v"(t));
            { const int rl = t & 255, which = t >> 8; const f32x4 p = *(const LAS f32x4*)(part + which * 1024 + rl * 4);
              vstat[(size_t)(u.pm * BM + rl) * 8 + which * 4 + (u.pn - 4)] = (p.x + p.y) + (p.z + p.w); }
        }
    }
};
struct EpiPair {
    bf16_t* O; int ldc; const float* ss; int silu; unsigned adj;
    __device__ __forceinline__ void operator()(const f32x4 (&acc)[2][2][4][2], const Unit& u, int wr, int wc, int fr, int fq) const {
        const int row0 = u.pm * BM + wr * 64 + fr, col0 = u.pn * HALF + wc * 32 + 8 * fq;
        float rsv[2][4]; rstd8(ss, row0, rsv);
#pragma unroll
        for (int ai = 0; ai < 2; ++ai)
#pragma unroll
            for (int m = 0; m < 4; ++m) { const int row = row0 + ai * HALF + m * 16; const float rs = rsv[ai][m];
                f32x4 g0 = acc[ai][0][m][0] * rs, g1 = acc[ai][0][m][1] * rs; const f32x4 t0 = acc[ai][1][m][0] * rs, t1 = acc[ai][1][m][1] * rs;
                if (silu) {
#pragma unroll
                    for (int j = 0; j < 4; ++j) { g0[j] = silu_f(g0[j]); g1[j] = silu_f(g1[j]); } }
                g0 = g0 * t0; g1 = g1 * t1;
                u32x4 w; w.x = cvt_pk_bf16(g0[0], g0[1]); w.y = cvt_pk_bf16(g0[2], g0[3]); w.z = cvt_pk_bf16(g1[0], g1[1]); w.w = cvt_pk_bf16(g1[2], g1[3]);
                *(u32x4*)(O + (size_t)row * ldc + col0 + (size_t)(row >> 12) * adj) = w; }
    }
    static constexpr bool DEFER = true;
    __device__ __forceinline__ void compute(const f32x4 (&acc)[2][2][4][2], const Unit& u, int wr, int wc, int fr, int fq, u32x4 (&pk)[8], unsigned& doff) const {
        const int row0 = u.pm * BM + wr * 64 + fr, col0 = u.pn * HALF + wc * 32 + 8 * fq;
        float rsv[2][4]; rstd8(ss, row0, rsv);
        doff = (unsigned)(((size_t)row0 * ldc + col0 + (size_t)(row0 >> 12) * adj) * 2);
#pragma unroll
        for (int ai = 0; ai < 2; ++ai)
#pragma unroll
            for (int m = 0; m < 4; ++m) { const float rs = rsv[ai][m];
                f32x4 g0 = acc[ai][0][m][0] * rs, g1 = acc[ai][0][m][1] * rs; const f32x4 t0 = acc[ai][1][m][0] * rs, t1 = acc[ai][1][m][1] * rs;
                if (silu) {
#pragma unroll
                    for (int j = 0; j < 4; ++j) { g0[j] = silu_f(g0[j]); g1[j] = silu_f(g1[j]); } }
                g0 = g0 * t0; g1 = g1 * t1;
                u32x4 w; w.x = cvt_pk_bf16(g0[0], g0[1]); w.y = cvt_pk_bf16(g0[2], g0[3]); w.z = cvt_pk_bf16(g1[0], g1[1]); w.w = cvt_pk_bf16(g1[2], g1[3]);
                pk[ai * 4 + m] = w; }
    }
    __device__ __forceinline__ void store_i(int i, const u32x4& v, unsigned doff) const {
        const unsigned vo = doff + (unsigned)((i >> 2) * HALF + (i & 3) * 16) * (unsigned)(ldc * 2); const char* sb = (const char*)O;
        asm volatile("global_store_dwordx4 %0, %1, %2" :: "v"(vo), "v"(v), "s"(sb) : "memory"); }
};
struct EpiRes {
    static constexpr bool DEFER = false;
    bf16_t* xb; float* ssn; LAS unsigned char* lds;
    __device__ __forceinline__ void operator()(const f32x4 (&acc)[2][2][4][2], const Unit& u, int wr, int wc, int fr, int fq) const {
        const int row0 = u.pm * BM + wr * 64 + fr, col0 = u.pn * BM + wc * 32 + 8 * fq;
        LAS float* part = (LAS float*)(lds + PART_OFF);
        u32x4 bb[2][4][2];
#pragma unroll
        for (int ai = 0; ai < 2; ++ai)
#pragma unroll
            for (int m = 0; m < 4; ++m)
#pragma unroll
                for (int bj = 0; bj < 2; ++bj) bb[ai][m][bj] = *(const u32x4*)(xb + (size_t)(row0 + ai * HALF + m * 16) * D + col0 + bj * HALF);
#pragma unroll
        for (int ai = 0; ai < 2; ++ai)
#pragma unroll
            for (int m = 0; m < 4; ++m) { const size_t off = (size_t)(row0 + ai * HALF + m * 16) * D + col0; float sq = 0.f;
#pragma unroll
                for (int bj = 0; bj < 2; ++bj) { const u32x4 b = bb[ai][m][bj];
                    const f32x4 v0 = acc[ai][bj][m][0] + (f32x4){bflo(b.x), bfhi(b.x), bflo(b.y), bfhi(b.y)}, v1 = acc[ai][bj][m][1] + (f32x4){bflo(b.z), bfhi(b.z), bflo(b.w), bfhi(b.w)};
                    u32x4 w; w.x = cvt_pk_bf16(v0[0], v0[1]); w.y = cvt_pk_bf16(v0[2], v0[3]); w.z = cvt_pk_bf16(v1[0], v1[1]); w.w = cvt_pk_bf16(v1[2], v1[3]);
                    *(u32x4*)(xb + off + bj * HALF) = w;
                    const float r0 = bflo(w.x), r1 = bfhi(w.x), r2 = bflo(w.y), r3 = bfhi(w.y), r4 = bflo(w.z), r5 = bfhi(w.z), r6 = bflo(w.w), r7 = bfhi(w.w);
                    sq += ((r0 * r0 + r1 * r1) + (r2 * r2 + r3 * r3)) + ((r4 * r4 + r5 * r5) + (r6 * r6 + r7 * r7)); }
                sq += __shfl_xor(sq, 16); sq += __shfl_xor(sq, 32);
                if (fq == 0) part[(ai * HALF + wr * 64 + m * 16 + fr) * 4 + wc] = sq; }
        asm volatile("s_waitcnt lgkmcnt(0)" ::: "memory"); __builtin_amdgcn_s_barrier(); asm volatile("" ::: "memory");
        int t = threadIdx.x; asm volatile("" : "+v"(t));
        if (t < 256) { const f32x4 p = *(const LAS f32x4*)(part + t * 4); ssn[(size_t)(u.pm * BM + t) * 4 + u.pn] = (p.x + p.y) + (p.z + p.w); }
    }
};

struct EpiResFin {
    static constexpr bool DEFER = false;
    const bf16_t* xb; float* ssn; float* out; const float* gfin; unsigned* pcnt; LAS unsigned char* lds;
    __device__ __forceinline__ void operator()(f32x4 (&acc)[2][2][4][2], const Unit& u, int wr, int wc, int fr, int fq) const {
        const int row0 = u.pm * BM + wr * 64 + fr, col0 = u.pn * BM + wc * 32 + 8 * fq;
        LAS float* part = (LAS float*)(lds + PART_OFF); LAS float* rstab = part + 1024;
        u32x4 bb[2][4][2];
#pragma unroll
        for (int ai = 0; ai < 2; ++ai)
#pragma unroll
            for (int m = 0; m < 4; ++m)
#pragma unroll
                for (int bj = 0; bj < 2; ++bj) bb[ai][m][bj] = *(const u32x4*)(xb + (size_t)(row0 + ai * HALF + m * 16) * D + col0 + bj * HALF);
#pragma unroll
        for (int ai = 0; ai < 2; ++ai)
#pragma unroll
            for (int m = 0; m < 4; ++m) { float sq = 0.f;
#pragma unroll
                for (int bj = 0; bj < 2; ++bj) { const u32x4 b = bb[ai][m][bj];
                    const f32x4 v0 = acc[ai][bj][m][0] + (f32x4){bflo(b.x), bfhi(b.x), bflo(b.y), bfhi(b.y)}, v1 = acc[ai][bj][m][1] + (f32x4){bflo(b.z), bfhi(b.z), bflo(b.w), bfhi(b.w)};
                    acc[ai][bj][m][0] = v0; acc[ai][bj][m][1] = v1;
                    sq += ((v0[0] * v0[0] + v0[1] * v0[1]) + (v0[2] * v0[2] + v0[3] * v0[3])) + ((v1[0] * v1[0] + v1[1] * v1[1]) + (v1[2] * v1[2] + v1[3] * v1[3])); }
                sq += __shfl_xor(sq, 16); sq += __shfl_xor(sq, 32);
                if (fq == 0) part[(ai * HALF + wr * 64 + m * 16 + fr) * 4 + wc] = sq; }
        asm volatile("s_waitcnt lgkmcnt(0)" ::: "memory"); __builtin_amdgcn_s_barrier(); asm volatile("" ::: "memory");
        int t = threadIdx.x; asm volatile("" : "+v"(t));
        if (t < 256) { const f32x4 p = *(const LAS f32x4*)(part + t * 4); __hip_atomic_store(ssn + (size_t)(u.pm * BM + t) * 4 + u.pn, (p.x + p.y) + (p.z + p.w), __ATOMIC_RELAXED, __HIP_MEMORY_SCOPE_AGENT); }
        asm volatile("s_waitcnt vmcnt(0)" ::: "memory"); __builtin_amdgcn_s_barrier(); asm volatile("" ::: "memory");
        if (t == 0) { unsigned* c = pcnt + 8 * u.pm; (void)__hip_atomic_fetch_add(c, 1u, __ATOMIC_RELAXED, __HIP_MEMORY_SCOPE_AGENT);
            unsigned sp = 0; while (__hip_atomic_load(c, __ATOMIC_RELAXED, __HIP_MEMORY_SCOPE_AGENT) < 4u) { __builtin_amdgcn_s_sleep(1); if (++sp > (1u << 22)) break; }
            __builtin_amdgcn_fence(__ATOMIC_ACQUIRE, "agent"); asm volatile("s_waitcnt vmcnt(0)" ::: "memory"); }
        asm volatile("" ::: "memory"); __builtin_amdgcn_s_barrier(); asm volatile("" ::: "memory");
        if (t < 256) { const float* pp = ssn + (size_t)(u.pm * BM + t) * 4;
            const float p0 = __hip_atomic_load(pp, __ATOMIC_RELAXED, __HIP_MEMORY_SCOPE_AGENT), p1 = __hip_atomic_load(pp + 1, __ATOMIC_RELAXED, __HIP_MEMORY_SCOPE_AGENT),
                        p2 = __hip_atomic_load(pp + 2, __ATOMIC_RELAXED, __HIP_MEMORY_SCOPE_AGENT), p3 = __hip_atomic_load(pp + 3, __ATOMIC_RELAXED, __HIP_MEMORY_SCOPE_AGENT);
            rstab[t] = __builtin_amdgcn_rsqf(((p0 + p1) + (p2 + p3)) * (1.0f / D) + EPS); }
        asm volatile("s_waitcnt lgkmcnt(0)" ::: "memory"); __builtin_amdgcn_s_barrier(); asm volatile("" ::: "memory");
        f32x4 gg[2][2];
#pragma unroll
        for (int bj = 0; bj < 2; ++bj) { gg[bj][0] = *(const f32x4*)(gfin + col0 + bj * HALF); gg[bj][1] = *(const f32x4*)(gfin + col0 + bj * HALF + 4); }
#pragma unroll
        for (int ai = 0; ai < 2; ++ai)
#pragma unroll
            for (int m = 0; m < 4; ++m) { const int rl = ai * HALF + wr * 64 + m * 16 + fr; const float rs = rstab[rl]; float* orow = out + (size_t)(u.pm * BM + rl) * D + col0;
#pragma unroll
                for (int bj = 0; bj < 2; ++bj) { *(f32x4*)(orow + bj * HALF) = acc[ai][bj][m][0] * gg[bj][0] * rs; *(f32x4*)(orow + bj * HALF + 4) = acc[ai][bj][m][1] * gg[bj][1] * rs; } }
    }
};

template <class Epi, bool ALIGN_EPI>
__device__ __forceinline__ void gemm_phase(LAS unsigned char* lds, const Gemm g, const StaticOrder& S, const Epi& E) {
    int tid = threadIdx.x; asm volatile("" : "+v"(tid));
    const int wid = __builtin_amdgcn_readfirstlane(tid >> 6), lane = tid & 63, wr = wid >> 2, wc = wid & 3, fr = lane & 15, fq = lane >> 4;
    const int K = g.K, nt = K / BK, lda = g.lda;
    unsigned voffA[2], voffB[2];
#pragma unroll
    for (int i = 0; i < 2; ++i) { int R, C; stage_rc(tid * 16 + i * 8192, R, C); const int Rb = (R & ~31) + perm32(R & 31);
        voffA[i] = (unsigned)(R * lda + C) * 2u; voffB[i] = (unsigned)(Rb * K + C) * 2u; }
    const size_t kstep = (size_t)(BK * 2);
    const size_t hstepA = (size_t)HALF * lda * 2, hstepB = (size_t)HALF * K * 2;
    const size_t tstepA = 2 * hstepA, tstepB = 2 * hstepB;
    const unsigned ldsw = (unsigned)wid * 1024u;
    const unsigned ldsb = (unsigned)(unsigned long)lds + ldsw;
    const int aoff = lds_byte(wr * 64 + fr, fq * 8), boff = lds_byte(wc * 32 + fr, fq * 8);
#define PG8_SA(b, h) (((b) * 2 + (h)) * HTB)
#define PG8_SB(b, h) ((4 + (b) * 2 + (h)) * HTB)
#define PG8_STAGE(bufoff, gbase, voff) do { _Pragma("unroll") for (int _i = 0; _i < 2; ++_i) { \
        const unsigned _m0 = ldsb + (unsigned)((bufoff) + _i * 8192); const char* _gb = (const char*)(gbase); \
        asm volatile("s_mov_b32 m0, %0\n\ts_nop 0\n\tglobal_load_lds_dwordx4 %1, %2" :: "s"(_m0), "v"((voff)[_i]), "s"(_gb) : "m0", "memory"); } } while (0)
#define PG8_LDA(dst, b, h) do { _Pragma("unroll") for (int m = 0; m < 4; ++m) _Pragma("unroll") for (int k = 0; k < 2; ++k) dst[m][k] = *(const LAS bf16x8*)(lds + PG8_SA(b, h) + aoff + m * 2048 + k * 1024); } while (0)
#define PG8_LDB(dst, b, h) do { _Pragma("unroll") for (int n = 0; n < 2; ++n) _Pragma("unroll") for (int k = 0; k < 2; ++k) dst[n][k] = *(const LAS bf16x8*)(lds + PG8_SB(b, h) + boff + n * 2048 + k * 1024); } while (0)
#define PG8_MMA(ai, bj, At, Bt) do { __builtin_amdgcn_s_setprio(1); _Pragma("unroll") for (int m = 0; m < 4; ++m) _Pragma("unroll") for (int n = 0; n < 2; ++n) _Pragma("unroll") for (int k = 0; k < 2; ++k) \
        acc[ai][bj][m][n] = __builtin_amdgcn_mfma_f32_16x16x32_bf16(Bt[n][k], At[m][k], acc[ai][bj][m][n], 0, 0, 0); __builtin_amdgcn_s_setprio(0); } while (0)
#define PG8_WAIT_V(n) asm volatile("s_waitcnt vmcnt(" #n ")" ::: "memory")
#define PG8_WAIT_L(n) asm volatile("s_waitcnt lgkmcnt(" #n ")" ::: "memory")
#define PG8_BAR __builtin_amdgcn_s_barrier()
#define PG8_SCHED __builtin_amdgcn_sched_barrier(0)
    Unit cur, nxt; int ui = 0;
    if (!S.next(0, cur)) return;
    f32x4 acc[2][2][4][2];
#pragma unroll
    for (int a = 0; a < 2; ++a)
#pragma unroll
        for (int b = 0; b < 2; ++b)
#pragma unroll
            for (int m = 0; m < 4; ++m)
#pragma unroll
                for (int n = 0; n < 2; ++n) acc[a][b][m][n] = (f32x4){0.f, 0.f, 0.f, 0.f};
    bf16x8 At[4][2], B0[2][2], B1[2][2];
    u32x4 pk[8]; unsigned doff = 0u;
    const char* cA = (const char*)g.A + (size_t)cur.pm * tstepA + (size_t)cur.pn * g.a_pn_off * 2 + (size_t)(cur.pm >> 4) * g.a_adj; const char* cB = (const char*)g.Bt + (size_t)cur.pn * tstepB;
    PG8_STAGE(PG8_SB(0, 0), cB, voffB); PG8_STAGE(PG8_SB(0, 1), cB + hstepB, voffB); PG8_STAGE(PG8_SA(0, 0), cA, voffA); PG8_STAGE(PG8_SA(0, 1), cA + hstepA, voffA);
    if (wr == 1) PG8_BAR;
    PG8_WAIT_V(2); PG8_BAR;
    PG8_STAGE(PG8_SB(1, 0), cB + kstep, voffB); PG8_STAGE(PG8_SA(1, 0), cA + kstep, voffA); PG8_STAGE(PG8_SB(1, 1), cB + hstepB + kstep, voffB);
    PG8_WAIT_V(6); PG8_BAR;
    for (;;) {
        const bool has_next = S.next(ui + 1, nxt);
        const char* nA = has_next ? (const char*)g.A + (size_t)nxt.pm * tstepA + (size_t)nxt.pn * g.a_pn_off * 2 + (size_t)(nxt.pm >> 4) * g.a_adj : cA; const char* nB = has_next ? (const char*)g.Bt + (size_t)nxt.pn * tstepB : cB;
#define PG8_ITER(H1, H2, H3, H4) do { \
            const bool last = (t == nt - 2); \
            const char* a1 = cA + (size_t)(t + 1) * kstep; \
            const char* a2 = last ? nA : cA + (size_t)(t + 2) * kstep; const char* b2 = last ? nB : cB + (size_t)(t + 2) * kstep; \
            const char* a3 = a2 + kstep; const char* b3 = b2 + kstep; \
            PG8_LDB(B0, 0, 0); PG8_LDB(B1, 0, 1); PG8_SCHED; PG8_LDA(At, 0, 0); PG8_STAGE(PG8_SA(1, 1), a1 + hstepA, voffA); \
            PG8_WAIT_V(8); PG8_WAIT_L(0); PG8_BAR; PG8_MMA(0, 0, At, B0); H1; PG8_MMA(0, 1, At, B1); PG8_BAR; PG8_SCHED; \
            PG8_LDA(At, 0, 1); PG8_STAGE(PG8_SB(0, 0), b2, voffB); PG8_STAGE(PG8_SB(0, 1), b2 + hstepB, voffB); PG8_STAGE(PG8_SA(0, 0), a2, voffA); \
            PG8_WAIT_V(8); PG8_WAIT_L(0); PG8_BAR; PG8_MMA(1, 0, At, B0); H2; PG8_MMA(1, 1, At, B1); PG8_BAR; PG8_SCHED; \
            PG8_LDB(B0, 1, 0); PG8_LDB(B1, 1, 1); PG8_SCHED; PG8_LDA(At, 1, 0); PG8_STAGE(PG8_SA(0, 1), a2 + hstepA, voffA); \
            PG8_WAIT_V(8); PG8_WAIT_L(0); PG8_BAR; PG8_MMA(0, 0, At, B0); H3; PG8_MMA(0, 1, At, B1); PG8_BAR; PG8_SCHED; \
            PG8_LDA(At, 1, 1); PG8_STAGE(PG8_SB(1, 0), b3, voffB); PG8_STAGE(PG8_SB(1, 1), b3 + hstepB, voffB); PG8_STAGE(PG8_SA(1, 0), a3, voffA); \
            PG8_WAIT_V(8); PG8_WAIT_L(0); PG8_BAR; PG8_MMA(1, 0, At, B0); H4; PG8_MMA(1, 1, At, B1); PG8_BAR; PG8_SCHED; } while (0)
        int t = 0;
        if constexpr (Epi::DEFER) {
            if (ui > 0) { PG8_ITER((E.store_i(0, pk[0], doff), E.store_i(1, pk[1], doff)), (E.store_i(2, pk[2], doff), E.store_i(3, pk[3], doff)),
                                   (E.store_i(4, pk[4], doff), E.store_i(5, pk[5], doff)), (E.store_i(6, pk[6], doff), E.store_i(7, pk[7], doff))); t = 2; }
        }
        for (; t < nt; t += 2) { PG8_ITER((void)0, (void)0, (void)0, (void)0); }
#undef PG8_ITER
        if constexpr (ALIGN_EPI) { if (wr == 0) PG8_BAR; }
        if constexpr (Epi::DEFER) { E.compute(acc, cur, wr, wc, fr, fq, pk, doff);
            if (!has_next) {
#pragma unroll
                for (int i = 0; i < 8; ++i) E.store_i(i, pk[i], doff); } }
        else E(acc, cur, wr, wc, fr, fq);
        if (!has_next) break;
#pragma unroll
        for (int a = 0; a < 2; ++a)
#pragma unroll
            for (int b = 0; b < 2; ++b)
#pragma unroll
                for (int m = 0; m < 4; ++m)
#pragma unroll
                    for (int n = 0; n < 2; ++n) acc[a][b][m][n] = (f32x4){0.f, 0.f, 0.f, 0.f};
        cur = nxt; cA = nA; cB = nB; ++ui;
        if constexpr (ALIGN_EPI) { if (wr == 1) PG8_BAR; }
    }
    PG8_WAIT_V(0);
    if constexpr (!ALIGN_EPI) { if (wr == 0) PG8_BAR; }
    PG8_BAR;
#undef PG8_SA
#undef PG8_SB
#undef PG8_STAGE
#undef PG8_LDA
#undef PG8_LDB
#undef PG8_MMA
#undef PG8_WAIT_V
#undef PG8_WAIT_L
#undef PG8_BAR
#undef PG8_SCHED
}
}

#define LDS_WAIT() asm volatile("s_waitcnt lgkmcnt(0)" ::: "memory")
__device__ __forceinline__ unsigned f2bf(float f) { unsigned u = __builtin_bit_cast(unsigned, f); return (u + 0x7fffu + ((u >> 16) & 1u)) >> 16; }
__device__ __forceinline__ unsigned pk2(float lo, float hi) { return pg8::cvt_pk_bf16(lo, hi); }
__device__ __forceinline__ float wave_sum(float v) {
#pragma unroll
    for (int o = 1; o < 64; o <<= 1) v += __shfl_xor(v, o);
    return v;
}

__device__ __forceinline__ int tid_opaque() { int t = threadIdx.x; asm volatile("" : "+v"(t)); return t; }
__device__ __forceinline__ int sgpr_opaque(int x) { asm volatile("" : "+s"(x)); return x; }
struct Args { const float* in[19]; float* out; unsigned char* ws; int ph_lo, ph_hi; };
constexpr int TBL_OFF = 131072 + 1024;
struct PT { LAS unsigned long long* tbl; };
__device__ __forceinline__ unsigned long long ldp(const PT& T, int i) {
    const unsigned long long v = T.tbl[i]; const unsigned lo = __builtin_amdgcn_readfirstlane((unsigned)v), hi = __builtin_amdgcn_readfirstlane((unsigned)(v >> 32));
    return ((unsigned long long)hi << 32) | lo; }
#define INP(i) ((const float*)ldp(T, (i)))
#define OUTP ((float*)ldp(T, 19))
#define WSP ((unsigned char*)ldp(T, 20))

__device__ __forceinline__ void tr_item(const float* W, int ldn, int N, bf16_t* WT, int ldk, const float* gain, int rbase, int rstride, LAS float* scr, int item, int lane) {
    const int nblk = N / 32, kb = item / nblk, nb = item % nblk, k0 = 64 * kb, n0 = 32 * nb;
    f32x4 v[8]; float gk[8];
#pragma unroll
    for (int i = 0; i < 8; ++i) { const int kk = 8 * i + (lane >> 3); v[i] = *(const f32x4*)(W + (size_t)(k0 + kk) * ldn + n0 + 4 * (lane & 7)); gk[i] = gain ? gain[k0 + kk] : 1.0f; }
#pragma unroll
    for (int i = 0; i < 8; ++i) { LAS float* d = scr + (8 * i + (lane >> 3)) * 33 + 4 * (lane & 7); d[0] = v[i].x * gk[i]; d[1] = v[i].y * gk[i]; d[2] = v[i].z * gk[i]; d[3] = v[i].w * gk[i]; }
    LDS_WAIT(); asm volatile("" ::: "memory");
    const int c = lane & 7;
#pragma unroll
    for (int j = 0; j < 4; ++j) { const int n = (lane >> 3) + 8 * j; const LAS float* s = scr + (8 * c) * 33 + n;
        u32x4 o; o.x = pk2(s[0 * 33], s[1 * 33]); o.y = pk2(s[2 * 33], s[3 * 33]); o.z = pk2(s[4 * 33], s[5 * 33]); o.w = pk2(s[6 * 33], s[7 * 33]);
        const int nn = n0 + n, dest = rbase + (nn >> 7) * rstride + (nn & 127);
        *(u32x4*)(WT + (size_t)dest * ldk + k0 + 8 * c) = o; }
    LDS_WAIT(); asm volatile("" ::: "memory");
}

__device__ __forceinline__ void prep_phase(const PT& T, LAS unsigned char* lds) {
    const int tid = tid_opaque(), lane = tid & 63, wave = __builtin_amdgcn_readfirstlane(tid >> 6);
    const int G = sgpr_opaque(gridDim.x), bid = sgpr_opaque(blockIdx.x), gw = bid * NWAVES + wave, NGW = G * NWAVES;
    LAS float* scr = (LAS float*)(lds + wave * 16384);
    bf16_t* Wb = (bf16_t*)(WSP + WS_W);
    constexpr int I_1Kx1K = (D / 64) * (D / 32), I_1Kx2K = (D / 64) * (2048 / 32), I_GRP = (256 / 64) * (256 / 32), I_UP = (D / 64) * (FH / 32), I_DN = (FH / 64) * (D / 32);
    constexpr int NITEMS = 2 * (I_1Kx2K + I_1Kx1K) + 4 * I_1Kx1K + 2 * I_1Kx1K + 4 * I_GRP + 4 * (2 * I_UP + I_DN);
    for (int it = gw; it < NITEMS; it += NGW) {
        int r = it;
#define TRJ(cnt, W, ldn, N, WT, ldk, gain, rbase, rstride) if (r >= 0) { if (r < (cnt)) { tr_item((W), (ldn), (N), (WT), (ldk), (gain), (rbase), (rstride), scr, r, lane); r = -1; } else r -= (cnt); }
        TRJ(I_1Kx2K, INP(4), 2048, 2048, Wb + WO_A_IN0, D, INP(1) + 0 * D, 0, 128)
        TRJ(I_1Kx1K, INP(8), D, D, Wb + WO_A_OUT0, D, nullptr, 0, 128)
        TRJ(I_1Kx2K, INP(4) + (size_t)D * 2048, 2048, 2048, Wb + WO_A_STRIDE + WO_A_IN0, D, INP(1) + 3 * D, 0, 128)
        TRJ(I_1Kx1K, INP(8) + (size_t)D * D, D, D, Wb + WO_A_STRIDE + WO_A_OUT0, D, nullptr, 0, 128)
        TRJ(I_1Kx1K, INP(9), 3 * D, D, Wb + WO_B_B, D, INP(1) + 1 * D, 0, 128)
        TRJ(I_1Kx1K, INP(9) + D, 3 * D, D, Wb + WO_B_CX, D, INP(1) + 1 * D, 0, 256)
        TRJ(I_1Kx1K, INP(9) + 2 * D, 3 * D, D, Wb + WO_B_CX, D, INP(1) + 1 * D, 128, 256)
        TRJ(I_1Kx1K, INP(11), D, D, Wb + WO_B_OUT, D, nullptr, 0, 128)
        TRJ(I_1Kx1K, INP(12), D, D, Wb + WO_C_IN, D, INP(1) + 2 * D, 0, 128)
        TRJ(I_1Kx1K, INP(15), D, D, Wb + WO_C_OUT, D, nullptr, 0, 128)
        TRJ(I_GRP, INP(13) + 0 * 65536, 256, 256, Wb + WO_C_GRP + 0 * 65536, 256, nullptr, 0, 128)
        TRJ(I_GRP, INP(13) + 1 * 65536, 256, 256, Wb + WO_C_GRP + 1 * 65536, 256, nullptr, 0, 128)
        TRJ(I_GRP, INP(13) + 2 * 65536, 256, 256, Wb + WO_C_GRP + 2 * 65536, 256, nullptr, 0, 128)
        TRJ(I_GRP, INP(13) + 3 * 65536, 256, 256, Wb + WO_C_GRP + 3 * 65536, 256, nullptr, 0, 128)
#pragma unroll
        for (int l = 0; l < 4; ++l) {
            TRJ(I_UP, INP(16) + (size_t)l * D * FH, FH, FH, Wb + WO_F_GU0 + l * WO_F_STRIDE, D, INP(2) + l * D, 0, 256)
            TRJ(I_UP, INP(17) + (size_t)l * D * FH, FH, FH, Wb + WO_F_GU0 + l * WO_F_STRIDE, D, INP(2) + l * D, 128, 256)
            TRJ(I_DN, INP(18) + (size_t)l * D * FH, D, D, Wb + WO_F_D0 + l * WO_F_STRIDE, FH, nullptr, 0, 128)
        }
#undef TRJ
    }
    const float* wsp6 = INP(6);
    for (int idx = bid * NTHR + tid; idx < 2 * 8 * 128 * 128; idx += G * NTHR) {
        const int i = (idx >> 7) & 127, j = idx & 127; const float w = wsp6[idx];
        (Wb + WO_A_S0 + (size_t)(idx >> 17) * WO_A_STRIDE)[idx & 131071] = (bf16_t)f2bf((i < 64 && j >= 64) ? 0.f : w);
    }
    bf16_t* XB = (bf16_t*)(WSP + WS_XB); float* ss0 = (float*)(WSP + WS_CTL);
    const float* xin = INP(0);
    for (int m = 4 * gw; m < M; m += 4 * NGW) {
        f32x4 v[4][4];
#pragma unroll
        for (int r = 0; r < 4; ++r)
#pragma unroll
            for (int j = 0; j < 4; ++j) v[r][j] = ((const f32x4*)(xin + (size_t)(m + r) * D) + lane)[64 * j];
#pragma unroll
        for (int r = 0; r < 4; ++r) { u32x2* o8 = (u32x2*)(XB + (size_t)(m + r) * D) + lane; float sq = 0.f;
#pragma unroll
            for (int j = 0; j < 4; ++j) { u32x2 w; w.x = pk2(v[r][j].x, v[r][j].y); w.y = pk2(v[r][j].z, v[r][j].w); o8[64 * j] = w;
                const float r0 = bflo(w.x), r1 = bfhi(w.x), r2 = bflo(w.y), r3 = bfhi(w.y); sq += (r0 * r0 + r1 * r1) + (r2 * r2 + r3 * r3); }
            sq = wave_sum(sq); if (lane == 0) *(f32x4*)(ss0 + 4 * (size_t)(m + r)) = (f32x4){sq, 0.f, 0.f, 0.f}; }
    }
}

__device__ __forceinline__ void spatial_phase(const PT& T, int a, LAS unsigned char* lds, int vc) {
    const int tid = tid_opaque(), lane = tid & 63, wid = __builtin_amdgcn_readfirstlane(tid >> 6), fr = lane & 15, fq = lane >> 4;
    const bf16_t* __restrict__ Z = (const bf16_t*)((unsigned char*)OUTP); bf16_t* __restrict__ Y = (bf16_t*)(WSP + WS_T2);
    const float* __restrict__ vst = (const float*)(WSP + WS_VST + (size_t)a * MiB);
    const float* __restrict__ gv = INP(5) + a * D; const float* __restrict__ bs = INP(7) + a * D;
    const bf16_t* __restrict__ Wm = (const bf16_t*)(WSP + WS_W) + WO_A_S0 + (size_t)a * WO_A_STRIDE;
    constexpr int LDW = 136;
    LAS bf16_t* sW = (LAS bf16_t*)lds; LAS bf16_t* sV = (LAS bf16_t*)(lds + 128 * LDW * 2);
    const int R8 = sgpr_opaque(gridDim.x) >> 3, vx = sgpr_opaque(vc) & 7, vr = sgpr_opaque(vc) >> 3;
    const int wi = wid >> 2, wc = wid & 3, ib = wi * 64, cb = wc * 32;
    const int jq = tid >> 4, c8 = (tid & 15) * 8;
    for (int ti = vr; ti < 256; ti += R8) {
        const int t = 256 * vx + ti, nb = t >> 3, g = t & 7;
        u32x4 wreg[4], vreg[4]; f32x4 p1[4], p2[4];
#pragma unroll
        for (int q = 0; q < 4; ++q) { const int j = jq + 32 * q; const size_t row = (size_t)nb * 128 + j;
            wreg[q] = *(const u32x4*)(Wm + (size_t)g * 16384 + j * 128 + c8);
            vreg[q] = *(const u32x4*)(Z + row * 2048 + 1024 + g * 128 + c8);
            p1[q] = *(const f32x4*)(vst + 8 * row); p2[q] = *(const f32x4*)(vst + 8 * row + 4); }
        const f32x4 g0 = *(const f32x4*)(gv + g * 128 + c8), g1 = *(const f32x4*)(gv + g * 128 + c8 + 4);
#pragma unroll
        for (int q = 0; q < 4; ++q) { const int j = jq + 32 * q;
            const float s1 = (p1[q].x + p1[q].y) + (p1[q].z + p1[q].w), s2 = (p2[q].x + p2[q].y) + (p2[q].z + p2[q].w);
            const float mu = s1 * (1.0f / D); float var = s2 * (1.0f / D) - mu * mu; var = var > 0.f ? var : 0.f; const float rs = __builtin_amdgcn_rsqf(var + EPS);
            const u32x4 raw = vreg[q];
            u32x4 o; o.x = pk2((bflo(raw.x) - mu) * rs * g0.x, (bfhi(raw.x) - mu) * rs * g0.y); o.y = pk2((bflo(raw.y) - mu) * rs * g0.z, (bfhi(raw.y) - mu) * rs * g0.w);
            o.z = pk2((bflo(raw.z) - mu) * rs * g1.x, (bfhi(raw.z) - mu) * rs * g1.y); o.w = pk2((bflo(raw.w) - mu) * rs * g1.z, (bfhi(raw.w) - mu) * rs * g1.w);
            *(LAS u32x4*)(sV + j * LDW + c8) = o; *(LAS u32x4*)(sW + j * LDW + c8) = wreg[q]; }
        u32x2 uu[4][2]; float bsv[4];
#pragma unroll
        for (int mt = 0; mt < 4; ++mt) { const int i = ib + 16 * mt + fr; bsv[mt] = bs[g * 128 + i];
#pragma unroll
            for (int n = 0; n < 2; ++n) uu[mt][n] = *(const u32x2*)(Z + ((size_t)nb * 128 + i) * 2048 + g * 128 + cb + 16 * n + 4 * fq); }
        __syncthreads();
        f32x4 acc[4][2];
#pragma unroll
        for (int mt = 0; mt < 4; ++mt)
#pragma unroll
            for (int n = 0; n < 2; ++n) acc[mt][n] = (f32x4){0.f, 0.f, 0.f, 0.f};
        const int nk = wi == 0 ? 2 : 4;
        for (int kk = 0; kk < nk; ++kk) {
            bf16x8 bfr[4], af[2];
#pragma unroll
            for (int mt = 0; mt < 4; ++mt) bfr[mt] = *(const LAS bf16x8*)(sW + (ib + 16 * mt + fr) * LDW + kk * 32 + 8 * fq);
#pragma unroll
            for (int n = 0; n < 2; ++n)
#pragma unroll
                for (int e = 0; e < 8; ++e) af[n][e] = (short)sV[(kk * 32 + 8 * fq + e) * LDW + cb + 16 * n + fr];
#pragma unroll
            for (int mt = 0; mt < 4; ++mt)
#pragma unroll
                for (int n = 0; n < 2; ++n) acc[mt][n] = __builtin_amdgcn_mfma_f32_16x16x32_bf16(af[n], bfr[mt], acc[mt][n], 0, 0, 0);
        }
#pragma unroll
        for (int mt = 0; mt < 4; ++mt) { const int i = ib + 16 * mt + fr; const size_t row = (size_t)nb * 128 + i;
#pragma unroll
            for (int n = 0; n < 2; ++n) { const int c = g * 128 + cb + 16 * n + 4 * fq; const u32x2 u2 = uu[mt][n];
                u32x2 o; o.x = pk2(bflo(u2.x) * (acc[mt][n][0] + bsv[mt]), bfhi(u2.x) * (acc[mt][n][1] + bsv[mt])); o.y = pk2(bflo(u2.y) * (acc[mt][n][2] + bsv[mt]), bfhi(u2.y) * (acc[mt][n][3] + bsv[mt]));
                *(u32x2*)(Y + row * D + c) = o; } }
        __syncthreads();
    }
}

__device__ __forceinline__ void conv_phase(const PT& T, int vc) {
    const int tid = tid_opaque(), chunk = tid & 127, c8 = chunk * 8, rsub = tid >> 7, R8 = sgpr_opaque(gridDim.x) >> 3, vx = sgpr_opaque(vc) & 7, vr = sgpr_opaque(vc) >> 3;
    const bf16_t* __restrict__ Q = (const bf16_t*)((unsigned char*)OUTP) + (size_t)vx * CHUNK_ADJ; const bf16_t* __restrict__ Bg = Q + CHUNK_ADJ; bf16_t* __restrict__ YB = (bf16_t*)(WSP + WS_T2);
    float w[3][8];
#pragma unroll
    for (int k = 0; k < 3; ++k) { const f32x4 a = *(const f32x4*)(INP(10) + k * D + c8), b = *(const f32x4*)(INP(10) + k * D + c8 + 4);
        w[k][0] = a.x; w[k][1] = a.y; w[k][2] = a.z; w[k][3] = a.w; w[k][4] = b.x; w[k][5] = b.y; w[k][6] = b.z; w[k][7] = b.w; }
    for (int ri = vr * 4 + rsub; ri < 512; ri += R8 * 4) {
        const int run = 512 * vx + ri, r0 = run * 8, tt0 = r0 & (SEQ - 1);
        u32x4 q[10], b[8];
        q[0] = (u32x4){0u, 0u, 0u, 0u}; q[1] = q[0];
        if (tt0 >= 2) { q[0] = *(const u32x4*)(Q + (size_t)(r0 - 2) * D + c8); q[1] = *(const u32x4*)(Q + (size_t)(r0 - 1) * D + c8); }
#pragma unroll
        for (int i = 0; i < 8; ++i) { const size_t off = (size_t)(r0 + i) * D + c8; q[2 + i] = *(const u32x4*)(Q + off); b[i] = *(const u32x4*)(Bg + off); }
#pragma unroll
        for (int i = 0; i < 8; ++i) { const u32x4 q0 = q[i], q1 = q[i + 1], q2 = q[i + 2], bb = b[i]; u32x4 o;
#define CV(e, qa, qb, qc, bv, LOHI) (LOHI(bv) * (w[0][e] * LOHI(qa) + w[1][e] * LOHI(qb) + w[2][e] * LOHI(qc)))
            o.x = pk2(CV(0, q0.x, q1.x, q2.x, bb.x, bflo), CV(1, q0.x, q1.x, q2.x, bb.x, bfhi)); o.y = pk2(CV(2, q0.y, q1.y, q2.y, bb.y, bflo), CV(3, q0.y, q1.y, q2.y, bb.y, bfhi));
            o.z = pk2(CV(4, q0.z, q1.z, q2.z, bb.z, bflo), CV(5, q0.z, q1.z, q2.z, bb.z, bfhi)); o.w = pk2(CV(6, q0.w, q1.w, q2.w, bb.w, bflo), CV(7, q0.w, q1.w, q2.w, bb.w, bfhi));
#undef CV
            *(u32x4*)(YB + (size_t)(r0 + i) * D + c8) = o; }
    }
}

template <int W>
__device__ __forceinline__ void pool_run(const bf16_t* __restrict__ Pp, bf16_t* __restrict__ Dp, int r0, int tt0, int c8) {
    u32x4 v[W - 1 + 8];
#pragma unroll
    for (int k = 0; k < W - 1; ++k) v[k] = (tt0 - (W - 1) + k >= 0) ? *(const u32x4*)(Pp + (size_t)(r0 - (W - 1) + k) * D + c8) : (u32x4){0u, 0u, 0u, 0u};
#pragma unroll
    for (int i = 0; i < 8; ++i) v[W - 1 + i] = *(const u32x4*)(Pp + (size_t)(r0 + i) * D + c8);
    float s[8];
#pragma unroll
    for (int e = 0; e < 8; ++e) s[e] = 0.f;
#pragma unroll
    for (int k = 0; k < W - 1; ++k) { s[0] += bflo(v[k].x); s[1] += bfhi(v[k].x); s[2] += bflo(v[k].y); s[3] += bfhi(v[k].y); s[4] += bflo(v[k].z); s[5] += bfhi(v[k].z); s[6] += bflo(v[k].w); s[7] += bfhi(v[k].w); }
#pragma unroll
    for (int i = 0; i < 8; ++i) { const int tt = tt0 + i; const u32x4 x = v[W - 1 + i];
        const float p[8] = {bflo(x.x), bfhi(x.x), bflo(x.y), bfhi(x.y), bflo(x.z), bfhi(x.z), bflo(x.w), bfhi(x.w)};
#pragma unroll
        for (int e = 0; e < 8; ++e) s[e] += p[e];
        const int cnt = (tt + 1) < W ? (tt + 1) : W; const float inv = 1.0f / (float)cnt;
        u32x4 o; o.x = pk2(s[0] * inv - p[0], s[1] * inv - p[1]); o.y = pk2(s[2] * inv - p[2], s[3] * inv - p[3]); o.z = pk2(s[4] * inv - p[4], s[5] * inv - p[5]); o.w = pk2(s[6] * inv - p[6], s[7] * inv - p[7]);
        *(u32x4*)(Dp + (size_t)(r0 + i) * D + c8) = o;
        const u32x4 y = v[i];
        s[0] -= bflo(y.x); s[1] -= bfhi(y.x); s[2] -= bflo(y.y); s[3] -= bfhi(y.y); s[4] -= bflo(y.z); s[5] -= bfhi(y.z); s[6] -= bflo(y.w); s[7] -= bfhi(y.w); }
}
__device__ __forceinline__ void pool_phase(const PT& T, int vc) {
    const int tid = tid_opaque(), lane = tid & 63, wave = __builtin_amdgcn_readfirstlane(tid >> 6), R8 = sgpr_opaque(gridDim.x) >> 3, vx = sgpr_opaque(vc) & 7, vr = sgpr_opaque(vc) >> 3;
    const int g = wave & 3, c8 = (g * 32 + (lane & 31)) * 8, rsel = (wave >> 2) * 2 + (lane >> 5);
    const bf16_t* __restrict__ Pp = (const bf16_t*)((unsigned char*)OUTP) + (size_t)vx * CHUNK_ADJ; bf16_t* __restrict__ Dp = (bf16_t*)(WSP + WS_T2);
    for (int ri = vr * 4 + rsel; ri < 512; ri += R8 * 4) {
        const int run = 512 * vx + ri, r0 = run * 8, tt0 = r0 & (SEQ - 1);
        if (g == 0) pool_run<2>(Pp, Dp, r0, tt0, c8); else if (g == 1) pool_run<4>(Pp, Dp, r0, tt0, c8); else if (g == 2) pool_run<8>(Pp, Dp, r0, tt0, c8); else pool_run<16>(Pp, Dp, r0, tt0, c8);
    }
}

__device__ __forceinline__ void final_phase(const PT& T, int vc) {
    const int tid = tid_opaque(), lane = tid & 63, wave = tid >> 6, R8 = sgpr_opaque(gridDim.x) >> 3, vx = sgpr_opaque(vc) & 7, vr = sgpr_opaque(vc) >> 3;
    const float* ss = (const float*)(WSP + WS_CTL) + (size_t)8 * M * 4; const f32x4* gp = (const f32x4*)INP(3) + lane;
    f32x4 gg[4];
#pragma unroll
    for (int j = 0; j < 4; ++j) gg[j] = gp[64 * j];
    const bf16_t* XB = (const bf16_t*)(WSP + WS_XB); float* outp = OUTP;
    for (int mi = vr * NWAVES + wave; mi < 4096; mi += R8 * NWAVES) { const int m = 4096 * vx + mi; const float rs = pg8::rstd_of(ss, m); const u32x2* xr = (const u32x2*)(XB + (size_t)m * D) + lane; f32x4* orow = (f32x4*)(outp + (size_t)m * D) + lane;
#pragma unroll
        for (int j = 0; j < 4; ++j) { const u32x2 b = xr[64 * j]; orow[64 * j] = (f32x4){bflo(b.x), bfhi(b.x), bflo(b.y), bfhi(b.y)} * gg[j] * rs; } }
}

#define XB_TMO      128
#define XB_XCNT(j)  (256  + 64 * (j))
#define XB_XSUB(j)  (1280 + 64 * (j))
#define XB_XGEN(j)  (2304 + 64 * (j))
#define XB_TOP      3328
#define XB_TOPGEN   3392
#define XCD_BAR_WORDS 3456
#define XB_SPIN_CAP (1u << 18)
__device__ __forceinline__ unsigned xb_ld(unsigned* p)              { return __hip_atomic_load(p, __ATOMIC_RELAXED, __HIP_MEMORY_SCOPE_AGENT); }
__device__ __forceinline__ unsigned xb_add(unsigned* p, unsigned v) { return __hip_atomic_fetch_add(p, v, __ATOMIC_RELAXED, __HIP_MEMORY_SCOPE_AGENT); }
__device__ __forceinline__ unsigned xb_xcc_id() { return (unsigned)__builtin_amdgcn_s_getreg((3 << 11) | 20) & 0xFu; }
#define XB_SPIN(cond, bar) do { unsigned _sp = 0; while (cond) { __builtin_amdgcn_s_sleep(1); \
    if ((++_sp & 255u) == 0u) { if (xb_ld(&(bar)[XB_TMO])) break; if (_sp > XB_SPIN_CAP) { atomicAdd(&(bar)[XB_TMO], 1u); break; } } } } while (0)
#define XL_SUB(j)   (4096 + 64 * (j))
#define XL_GEN(j)   (5120 + 64 * (j))
#define XL_RANK(j)  (6144 + 64 * (j))
#define XL_PCNT     7168
__device__ __forceinline__ void xcc_barrier(unsigned* bar, unsigned x, unsigned nloc) {
    asm volatile("s_waitcnt vmcnt(0)" ::: "memory");
    __syncthreads();
    if (threadIdx.x == 0) {
        __builtin_amdgcn_s_waitcnt(0);
        const unsigned old = xb_add(&bar[XL_SUB(x)], 1u), gen = old / nloc;
        if (old + 1u == (gen + 1u) * nloc) xb_add(&bar[XL_GEN(x)], 1u); else XB_SPIN(xb_ld(&bar[XL_GEN(x)]) == gen, bar);
        __builtin_amdgcn_fence(__ATOMIC_ACQUIRE, "agent");
        asm volatile("s_waitcnt vmcnt(0)" ::: "memory");
    }
    __syncthreads();
}
__device__ __forceinline__ void xcd_barrier_post(unsigned* bar) { if (threadIdx.x == 0) (void)xb_add(&bar[XB_XCNT(xb_xcc_id())], 1u); }
__device__ __forceinline__ void xcd_barrier_complete(unsigned* bar, unsigned x, unsigned& nloc, unsigned& nx) {
    const unsigned G = gridDim.x * gridDim.y * gridDim.z;
    unsigned sum, cnt, mine, sp = 0u;
    for (;;) {
        sum = 0u; cnt = 0u; mine = 0u;
#pragma unroll
        for (unsigned j = 0; j < 16; ++j) { const unsigned c = xb_ld(&bar[XB_XCNT(j)]); sum += c; cnt += (c > 0u) ? 1u : 0u; mine = (j == x) ? c : mine; }
        if (sum == G) break;
        __builtin_amdgcn_s_sleep(1);
        if ((++sp & 255u) == 0u) { if (xb_ld(&bar[XB_TMO])) break; if (sp > XB_SPIN_CAP) { atomicAdd(&bar[XB_TMO], 1u); break; } }
    }
    nloc = mine > 0u ? mine : 1u; nx = cnt > 0u ? cnt : 1u;
}
__device__ __forceinline__ void xcd_barrier(unsigned* bar, volatile LAS unsigned* st) {
    asm volatile("s_waitcnt vmcnt(0)" ::: "memory");
    __syncthreads();
    if (threadIdx.x == 0) {
        const unsigned x = xb_xcc_id();
        __builtin_amdgcn_s_waitcnt(0);
        unsigned nloc = st[0], nx = st[1];
        if (nloc == 0u) { xcd_barrier_complete(bar, x, nloc, nx); st[0] = nloc; st[1] = nx; }
        const unsigned old = xb_add(&bar[XB_XSUB(x)], 1u);
        const unsigned gen = old / nloc;
        if (old + 1u == (gen + 1u) * nloc) {
            __builtin_amdgcn_fence(__ATOMIC_RELEASE, "agent");
            asm volatile("s_waitcnt vmcnt(0)" ::: "memory");
            const unsigned og = xb_add(&bar[XB_TOP], 1u);
            const unsigned tg = og / nx;
            if (og + 1u == (tg + 1u) * nx) xb_add(&bar[XB_TOPGEN], 1u);
            else XB_SPIN(xb_ld(&bar[XB_TOPGEN]) == tg, bar);
            __builtin_amdgcn_fence(__ATOMIC_ACQUIRE, "agent");
            xb_add(&bar[XB_XGEN(x)], 1u);
            asm volatile("s_waitcnt vmcnt(0)" ::: "memory");
        } else {
            XB_SPIN(xb_ld(&bar[XB_XGEN(x)]) == gen, bar);
            __builtin_amdgcn_fence(__ATOMIC_ACQUIRE, "agent");
            asm volatile("s_waitcnt vmcnt(0)" ::: "memory");
        }
    }
    __syncthreads();
}

constexpr int NPH = 30;
__global__ void __launch_bounds__(NTHR, 2) fwd_megakernel(Args P) {
    extern __shared__ __attribute__((aligned(16))) unsigned char lds_raw[];
    LAS unsigned char* lds = (LAS unsigned char*)lds_raw;
    cg::grid_group grid = cg::this_grid();
    PT T; T.tbl = (LAS unsigned long long*)(lds + TBL_OFF);
    if (threadIdx.x == 0) {
#pragma unroll
        for (int i = 0; i < 19; ++i) T.tbl[i] = (unsigned long long)P.in[i];
        T.tbl[19] = (unsigned long long)P.out; T.tbl[20] = (unsigned long long)P.ws;
    }
    volatile LAS unsigned* bst = (volatile LAS unsigned*)(lds + 131072 + 16);
    if (threadIdx.x < 2) bst[threadIdx.x] = 0u;
    __syncthreads();
    xcd_barrier_post((unsigned*)(P.ws + WS_BAR));
    if (threadIdx.x == 0) { unsigned* bar0 = (unsigned*)(P.ws + WS_BAR); const unsigned xc = xb_xcc_id(); bst[2] = xc; bst[3] = xb_add(&bar0[XL_RANK(xc)], 1u); }
    int nsync = 0, vc = blockIdx.x, teams = 0;
    bool pending = false;
    const int ph_hi = P.ph_hi;
    for (int ph = P.ph_lo; ph < ph_hi; ++ph) {
        const int L = (ph - 1) / 7, s = (ph - 1) % 7, kind = L % 3, a = L / 3;
        bool run = true;
        if (ph > 0 && ph < NPH - 1) { if (s == 1 && kind != 1) run = false; if (s == 3 && kind != 2) run = false; }
        if (ph == NPH - 1 && teams) continue;
        if (!run) continue;
        if (pending && !(ph > 0 && ph < NPH - 1 && s == 1)) {
            const bool gseam = nsync == 0 || !teams;
            if (P.ph_lo < 0) grid.sync(); else if (gseam) xcd_barrier((unsigned*)(WSP + WS_BAR), bst); else xcc_barrier((unsigned*)(WSP + WS_BAR), (unsigned)(vc & 7), gridDim.x >> 3);
            if (nsync == 0) {
                if (threadIdx.x == 0) { unsigned* bar0 = (unsigned*)(WSP + WS_BAR); const unsigned want = gridDim.x >> 3; unsigned okc = (gridDim.x & 7u) == 0u;
#pragma unroll
                    for (unsigned j = 0; j < 16; ++j) { const unsigned cj = xb_ld(&bar0[XL_RANK(j)]); okc &= (j < 8 ? cj == want : cj == 0u); }
                    bst[4] = okc; }
                __syncthreads();
                teams = __builtin_amdgcn_readfirstlane((int)bst[4]);
                if (teams) vc = (__builtin_amdgcn_readfirstlane((int)bst[3]) << 3) | __builtin_amdgcn_readfirstlane((int)bst[2]);
            }
            ++nsync; }
        pending = true;
        asm volatile("" ::: "memory");
        if (ph == 0) { prep_phase(T, lds); __syncthreads(); continue; }
        if (ph == NPH - 1) { final_phase(T, vc); continue; }
        if (s == 2) { if (kind == 0) spatial_phase(T, a, lds, vc); else if (kind == 1) conv_phase(T, vc); else pool_phase(T, vc); __syncthreads(); continue; }
        const int G = sgpr_opaque(gridDim.x), bidx = sgpr_opaque(vc);
        unsigned char* ws = WSP;
        const bf16_t* Wb = (const bf16_t*)(ws + WS_W);
        bf16_t* XB = (bf16_t*)(ws + WS_XB); bf16_t* H = (bf16_t*)(ws + WS_H); bf16_t* T1 = (bf16_t*)OUTP; bf16_t* T2 = (bf16_t*)(ws + WS_T2);
        float* ssb = (float*)(ws + WS_CTL);
        const float* ss_mix = ssb + (size_t)(2 * L) * M * 4; float* ss_ffn = ssb + (size_t)(2 * L + 1) * M * 4; float* ss_next = ssb + (size_t)(2 * L + 2) * M * 4;
        pg8::StaticOrder S;
        if (s == 0 && kind == 0) {
            pg8::Gemm g{XB, Wb + WO_A_IN0 + (size_t)a * WO_A_STRIDE, M, 2048, D, D, 0, 0u}; S.init(M, 2048, G, bidx);
            pg8::EpiGeluStats E{T1, 2048, ss_mix, (float*)(ws + WS_VST + (size_t)a * MiB), lds}; pg8::gemm_phase<pg8::EpiGeluStats, true>(lds, g, S, E);
        } else if ((s == 0 && kind == 1) || s == 5) {
            const bool ffn = s == 5; const int N = ffn ? 2 * FH : 2048;
            pg8::Gemm g{XB, Wb + (ffn ? WO_F_GU0 + (size_t)L * WO_F_STRIDE : WO_B_CX), M, N, D, D, 0, 0u}; S.init(M, N, G, bidx);
            pg8::EpiPair E{ffn ? H : T1, ffn ? FH : D, ffn ? ss_ffn : ss_mix, ffn ? 1 : 0, ffn ? 0u : CHUNK_ADJ}; pg8::gemm_phase<pg8::EpiPair, true>(lds, g, S, E);
        } else if (s == 0 || s == 1 || s == 3) {
            const bool grp = s == 3;
            pg8::Gemm g{grp ? T2 : XB, Wb + (grp ? WO_C_GRP : s == 1 ? WO_B_B : WO_C_IN), M, D, grp ? 256 : D, D, grp ? 256 : 0, 0u}; S.init(M, D, G, bidx);
            pg8::EpiPlain E{s == 0 ? T1 : T1 + CHUNK_ADJ, D, grp ? nullptr : ss_mix, grp ? INP(14) : nullptr, CHUNK_ADJ}; pg8::gemm_phase<pg8::EpiPlain, true>(lds, g, S, E);
        } else {
            const bool dn = s == 6;
            const bf16_t* Am = dn ? H : kind == 2 ? T1 + CHUNK_ADJ : T2;
            const bf16_t* Wm = Wb + (dn ? WO_F_D0 + (size_t)L * WO_F_STRIDE : kind == 0 ? WO_A_OUT0 + (size_t)a * WO_A_STRIDE : kind == 1 ? WO_B_OUT : WO_C_OUT);
            pg8::Gemm g{Am, Wm, M, D, dn ? FH : D, dn ? FH : D, 0, (!dn && kind == 2) ? 2u * CHUNK_ADJ : 0u}; S.init(M, D, G, bidx);
            if (dn && L == DEPTH - 1 && teams) { pg8::EpiResFin E{XB, ss_next, OUTP, INP(3), (unsigned*)(ws + WS_BAR) + XL_PCNT, lds}; pg8::gemm_phase<pg8::EpiResFin, true>(lds, g, S, E); }
            else { pg8::EpiRes E{XB, dn ? ss_next : ss_ffn, lds}; pg8::gemm_phase<pg8::EpiRes, true>(lds, g, S, E); }
        }
    }
}

extern "C" void kernel_launch(void* const* d_in, const int* in_sizes, int n_in, void* d_out, int out_size, void* d_ws, size_t ws_size, hipStream_t stream) {
    static int grid = 0;
    if (grid == 0) {
        if (n_in != 19 || in_sizes[0] != M * D || out_size != M * D || ws_size < WS_END) { fprintf(stderr, "kernel_launch: unexpected shapes (n_in %d, in0 %d, out %d, ws %zu)\n", n_in, n_in > 0 ? in_sizes[0] : -1, out_size, ws_size); grid = -1; return; }
        int dev = 0, cus = 0, per_cu = 0;
        hipGetDevice(&dev); hipDeviceGetAttribute(&cus, hipDeviceAttributeMultiprocessorCount, dev);
        hipFuncSetAttribute((const void*)fwd_megakernel, hipFuncAttributeMaxDynamicSharedMemorySize, LDS_BYTES);
        hipOccupancyMaxActiveBlocksPerMultiprocessor(&per_cu, (const void*)fwd_megakernel, NTHR, LDS_BYTES);
        (void)hipGetLastError();
        if (per_cu < 1) per_cu = 1;
        grid = cus * 1; if (grid != 256) { fprintf(stderr, "kernel_launch: built for 256 CUs (8 XCDs x 32: the fused final norm needs 32-workgroup XCD teams); this device reports %d\n", grid); grid = -1; return; }
        fprintf(stderr, "kernel_launch: cus %d per_cu %d grid %d\n", cus, per_cu, grid);
    }
    if (grid < 0) return;
    hipMemsetAsync((char*)d_ws + WS_BAR, 0, BAR_BYTES, stream);
    Args a{};
    for (int i = 0; i < 19; ++i) a.in[i] = (const float*)d_in[i];
    a.out = (float*)d_out; a.ws = (unsigned char*)d_ws; a.ph_lo = 0; a.ph_hi = NPH;
    void* args[] = {&a};
    hipError_t e = hipLaunchCooperativeKernel((const void*)fwd_megakernel, dim3(grid), dim3(NTHR), args, LDS_BYTES, stream);
    if (e != hipSuccess) fprintf(stderr, "cooperative launch failed: %s (grid %d)\n", hipGetErrorString(e), grid);
}
```

```cpp
#include <hip/hip_runtime.h>
#include <hip/hip_cooperative_groups.h>
#include <cstdio>
#include <cstdint>
namespace cg = cooperative_groups;

#define LAS __attribute__((address_space(3)))
typedef unsigned short bf16_t;
typedef short bf16x8 __attribute__((ext_vector_type(8)));
typedef float f32x4 __attribute__((ext_vector_type(4)));
typedef float f32x2 __attribute__((ext_vector_type(2)));
typedef unsigned u32x4 __attribute__((ext_vector_type(4)));
typedef unsigned u32x2 __attribute__((ext_vector_type(2)));

constexpr int D = 1024, BATCH = 16, SEQ = 2048, M = BATCH * SEQ, FH = 2816, DEPTH = 4;
constexpr float EPS = 1e-6f;
constexpr int NWAVES = 8, NTHR = 512;

constexpr size_t MiB = 1u << 20;
constexpr size_t WS_W = 4 * MiB;
constexpr size_t WS_XB = 96 * MiB;
constexpr size_t WS_H = 160 * MiB;
constexpr size_t WS_T1 = WS_H;
constexpr size_t WS_T2 = 336 * MiB;
constexpr size_t WS_CTL = 400 * MiB;
constexpr size_t WS_VST = WS_CTL + 5 * MiB;
constexpr size_t WS_BAR = WS_CTL + 7 * MiB, BAR_BYTES = 32768;
constexpr size_t WS_END = 408 * MiB;
constexpr size_t Mi = 1u << 20;
constexpr size_t WO_A_IN0 = 0, WO_A_OUT0 = WO_A_IN0 + 2 * Mi, WO_A_S0 = WO_A_OUT0 + Mi, WO_A_STRIDE = 3 * Mi + 128 * 1024;
constexpr size_t WO_B_CX = 2 * WO_A_STRIDE, WO_B_B = WO_B_CX + 2 * Mi, WO_B_OUT = WO_B_B + Mi;
constexpr size_t WO_C_IN = WO_B_OUT + Mi, WO_C_GRP = WO_C_IN + Mi, WO_C_OUT = WO_C_GRP + 256 * 1024;
constexpr size_t WO_F_GU0 = WO_C_OUT + Mi, WO_F_D0 = WO_F_GU0 + (size_t)2 * FH * D, WO_F_STRIDE = (size_t)3 * FH * D;
constexpr size_t WO_END = WO_F_GU0 + 4 * WO_F_STRIDE;
static_assert(WO_END * 2 <= WS_XB - WS_W, "weights fit");
static_assert(WS_H + (size_t)M * FH * 2 <= WS_T2, "H fits");

constexpr unsigned CHUNK_ADJ = 4u << 20;
constexpr int LDS_BYTES = 147456;

__device__ __forceinline__ float bflo(unsigned w) { return __builtin_bit_cast(float, w << 16); }
__device__ __forceinline__ float bfhi(unsigned w) { return __builtin_bit_cast(float, w & 0xffff0000u); }

namespace pg8 {
constexpr int BM = 256, BK = 64, HALF = 128, HTB = HALF * BK * 2, STAGE_BYTES = 8 * HTB, NXCD = 8, WGM = 4;
__host__ __device__ __forceinline__ int lds_byte(int r, int c) { const int st = (r >> 4) * 2 + (c >> 5), rr = r & 15, cc = c & 31, ob = rr * 64 + cc * 2; return st * 1024 + (ob ^ (((ob >> 9) & 1) << 5)); }
__host__ __device__ __forceinline__ void stage_rc(int b, int& R, int& C) { const int st = b / 1024, sb = b % 1024, swz = sb ^ (((sb >> 9) & 1) << 5); R = (st >> 1) * 16 + swz / 64; C = (st & 1) * 32 + (swz % 64) / 2; }
__host__ __device__ __forceinline__ int perm32(int rho) { const int n = rho >> 4, i = rho & 15; return 8 * (i >> 2) + 4 * n + (i & 3); }

struct Unit { int pm, pn; };
struct Gemm { const bf16_t* A; const bf16_t* Bt; int M, N, K, lda, a_pn_off; unsigned a_adj; };

struct StaticOrder {
    int nM, nN, nwg, G, c;
    __device__ void init(int M_, int N_, int G_, int c_) { nM = M_ / BM; nN = N_ / BM; nwg = nM * nN; G = G_; c = c_; }
    __device__ bool next(int i, Unit& u) const {
        const long L = (long)i * G + c; if (L >= nwg) return false;
        int wgid = (int)L; { const int q = nwg / NXCD, r = nwg % NXCD, xcd = wgid % NXCD, off = wgid / NXCD; wgid = (xcd < r ? xcd * (q + 1) : r * (q + 1) + (xcd - r) * q) + off; }
        const int nig = WGM * nN, gid = wgid / nig, fm = gid * WGM, gsz = (nM - fm) < WGM ? (nM - fm) : WGM;
        u.pm = fm + ((wgid % nig) % gsz); u.pn = (wgid % nig) / gsz; return true;
    }
};

__device__ __forceinline__ unsigned cvt_pk_bf16(float lo, float hi) { unsigned r; asm volatile("v_cvt_pk_bf16_f32 %0, %1, %2" : "=v"(r) : "v"(lo), "v"(hi)); return r; }
__device__ __forceinline__ f32x2 gelu_pk(f32x2 v) {
    const f32x2 av = __builtin_elementwise_abs(v), d = av * 0.2316418882f + 1.0f;
    f32x2 t; t.x = __builtin_amdgcn_rcpf(d.x); t.y = __builtin_amdgcn_rcpf(d.y);
    f32x2 q = t * 0.5307027145f + (-0.7265760135f); q = q * t + 0.7107068705f; q = q * t + (-0.142248368f); q = q * t + 0.127414796f; q = q * t;
    const f32x2 s = (v * v) * (-0.72134752044f);
    f32x2 e; e.x = __builtin_amdgcn_exp2f(s.x); e.y = __builtin_amdgcn_exp2f(s.y);
    const f32x2 m = v * (q * e), r = v - m;
    f32x2 o; o.x = v.x < 0.f ? m.x : r.x; o.y = v.y < 0.f ? m.y : r.y; return o;
}
__device__ __forceinline__ float rstd_of(const float* ss, int row) { const f32x4 p = *(const f32x4*)(ss + 4 * (size_t)row); return __builtin_amdgcn_rsqf(((p.x + p.y) + (p.z + p.w)) * (1.0f / D) + EPS); }
constexpr int PART_OFF = 131072 + 2048;
__device__ __forceinline__ float silu_f(float g) { return g * __builtin_amdgcn_rcpf(1.0f + __builtin_amdgcn_exp2f(g * -1.4426950408889634f)); }

__device__ __forceinline__ void rstd8(const float* ss, int row0, float (&rs)[2][4]) {
    f32x4 p[2][4];
#pragma unroll
    for (int ai = 0; ai < 2; ++ai)
#pragma unroll
        for (int m = 0; m < 4; ++m) p[ai][m] = *(const f32x4*)(ss + 4 * (size_t)(row0 + ai * HALF + m * 16));
#pragma unroll
    for (int ai = 0; ai < 2; ++ai)
#pragma unroll
        for (int m = 0; m < 4; ++m) rs[ai][m] = __builtin_amdgcn_rsqf(((p[ai][m].x + p[ai][m].y) + (p[ai][m].z + p[ai][m].w)) * (1.0f / D) + EPS);
}


struct EpiPlain {
    bf16_t* O; int ldc; const float* ss; const float* cscale; unsigned adj;
    __device__ __forceinline__ void operator()(const f32x4 (&acc)[2][2][4][2], const Unit& u, int wr, int wc, int fr, int fq) const {
        const int row0 = u.pm * BM + wr * 64 + fr, col0 = u.pn * BM + wc * 32 + 8 * fq;
        f32x4 cv[2][2];
#pragma unroll
        for (int bj = 0; bj < 2; ++bj)
#pragma unroll
            for (int n = 0; n < 2; ++n) cv[bj][n] = cscale ? *(const f32x4*)(cscale + col0 + bj * HALF + 4 * n) : (f32x4){1.f, 1.f, 1.f, 1.f};
        float rsv[2][4];
        if (ss) rstd8(ss, row0, rsv); else {
#pragma unroll
            for (int i = 0; i < 8; ++i) rsv[i >> 2][i & 3] = 1.0f; }
#pragma unroll
        for (int ai = 0; ai < 2; ++ai)
#pragma unroll
            for (int m = 0; m < 4; ++m) { const int row = row0 + ai * HALF + m * 16; const float rs = rsv[ai][m]; bf16_t* rowp = O + (size_t)row * ldc + col0 + (size_t)(row >> 12) * adj;
#pragma unroll
                for (int bj = 0; bj < 2; ++bj) { const f32x4 v0 = acc[ai][bj][m][0] * cv[bj][0] * rs, v1 = acc[ai][bj][m][1] * cv[bj][1] * rs;
                    u32x4 w; w.x = cvt_pk_bf16(v0[0], v0[1]); w.y = cvt_pk_bf16(v0[2], v0[3]); w.z = cvt_pk_bf16(v1[0], v1[1]); w.w = cvt_pk_bf16(v1[2], v1[3]);
                    *(u32x4*)(rowp + bj * HALF) = w; } }
    }
};
struct EpiGeluStats {
    bf16_t* O; int ldc; const float* ss; float* vstat; LAS unsigned char* lds;
    __device__ __forceinline__ void operator()(const f32x4 (&acc)[2][2][4][2], const Unit& u, int wr, int wc, int fr, int fq) const {
        const int row0 = u.pm * BM + wr * 64 + fr, col0 = u.pn * BM + wc * 32 + 8 * fq; const bool isv = u.pn >= 4;
        LAS float* part = (LAS float*)(lds + PART_OFF);
        float rsv[2][4]; rstd8(ss, row0, rsv);
#pragma unroll
        for (int ai = 0; ai < 2; ++ai)
#pragma unroll
            for (int m = 0; m < 4; ++m) { const int row = row0 + ai * HALF + m * 16; const float rs = rsv[ai][m]; bf16_t* rowp = O + (size_t)row * ldc + col0; float s1 = 0.f, s2 = 0.f;
#pragma unroll
                for (int bj = 0; bj < 2; ++bj) { f32x4 v0 = acc[ai][bj][m][0] * rs, v1 = acc[ai][bj][m][1] * rs;
                    const f32x2 a = gelu_pk((f32x2){v0[0], v0[1]}), b = gelu_pk((f32x2){v0[2], v0[3]}), c = gelu_pk((f32x2){v1[0], v1[1]}), d = gelu_pk((f32x2){v1[2], v1[3]});
                    s1 += ((a.x + a.y) + (b.x + b.y)) + ((c.x + c.y) + (d.x + d.y));
                    s2 += ((a.x * a.x + a.y * a.y) + (b.x * b.x + b.y * b.y)) + ((c.x * c.x + c.y * c.y) + (d.x * d.x + d.y * d.y));
                    u32x4 w; w.x = cvt_pk_bf16(a.x, a.y); w.y = cvt_pk_bf16(b.x, b.y); w.z = cvt_pk_bf16(c.x, c.y); w.w = cvt_pk_bf16(d.x, d.y);
                    *(u32x4*)(rowp + bj * HALF) = w; }
                if (isv) { s1 += __shfl_xor(s1, 16); s1 += __shfl_xor(s1, 32); s2 += __shfl_xor(s2, 16); s2 += __shfl_xor(s2, 32);
                    if (fq == 0) { const int rl = ai * HALF + wr * 64 + m * 16 + fr; part[rl * 4 + wc] = s1; part[1024 + rl * 4 + wc] = s2; } } }
        if (isv) {
            asm volatile("s_waitcnt lgkmcnt(0)" ::: "memory"); __builtin_amdgcn_s_barrier(); asm volatile("" ::: "memory");
            const int t = threadIdx.x;
            { const int rl = t & 255, which = t >> 8; const f32x4 p = *(const LAS f32x4*)(part + which * 1024 + rl * 4);
              vstat[(size_t)(u.pm * BM + rl) * 8 + which * 4 + (u.pn - 4)] = (p.x + p.y) + (p.z + p.w); }
        }
    }
};
struct EpiPair {
    bf16_t* O; int ldc; const float* ss; int silu; unsigned adj;
    __device__ __forceinline__ void operator()(const f32x4 (&acc)[2][2][4][2], const Unit& u, int wr, int wc, int fr, int fq) const {
        const int row0 = u.pm * BM + wr * 64 + fr, col0 = u.pn * HALF + wc * 32 + 8 * fq;
        float rsv[2][4]; rstd8(ss, row0, rsv);
#pragma unroll
        for (int ai = 0; ai < 2; ++ai)
#pragma unroll
            for (int m = 0; m < 4; ++m) { const int row = row0 + ai * HALF + m * 16; const float rs = rsv[ai][m];
                f32x4 g0 = acc[ai][0][m][0] * rs, g1 = acc[ai][0][m][1] * rs; const f32x4 t0 = acc[ai][1][m][0] * rs, t1 = acc[ai][1][m][1] * rs;
                if (silu) {
#pragma unroll
                    for (int j = 0; j < 4; ++j) { g0[j] = silu_f(g0[j]); g1[j] = silu_f(g1[j]); } }
                g0 = g0 * t0; g1 = g1 * t1;
                u32x4 w; w.x = cvt_pk_bf16(g0[0], g0[1]); w.y = cvt_pk_bf16(g0[2], g0[3]); w.z = cvt_pk_bf16(g1[0], g1[1]); w.w = cvt_pk_bf16(g1[2], g1[3]);
                *(u32x4*)(O + (size_t)row * ldc + col0 + (size_t)(row >> 12) * adj) = w; }
    }
};
struct EpiRes {
    bf16_t* xb; float* ssn; LAS unsigned char* lds;
    __device__ __forceinline__ void operator()(const f32x4 (&acc)[2][2][4][2], const Unit& u, int wr, int wc, int fr, int fq) const {
        const int row0 = u.pm * BM + wr * 64 + fr, col0 = u.pn * BM + wc * 32 + 8 * fq;
        LAS float* part = (LAS float*)(lds + PART_OFF);
        u32x4 bb[2][4][2];
#pragma unroll
        for (int ai = 0; ai < 2; ++ai)
#pragma unroll
            for (int m = 0; m < 4; ++m)
#pragma unroll
                for (int bj = 0; bj < 2; ++bj) bb[ai][m][bj] = *(const u32x4*)(xb + (size_t)(row0 + ai * HALF + m * 16) * D + col0 + bj * HALF);
#pragma unroll
        for (int ai = 0; ai < 2; ++ai)
#pragma unroll
            for (int m = 0; m < 4; ++m) { const size_t off = (size_t)(row0 + ai * HALF + m * 16) * D + col0; float sq = 0.f;
#pragma unroll
                for (int bj = 0; bj < 2; ++bj) { const u32x4 b = bb[ai][m][bj];
                    const f32x4 v0 = acc[ai][bj][m][0] + (f32x4){bflo(b.x), bfhi(b.x), bflo(b.y), bfhi(b.y)}, v1 = acc[ai][bj][m][1] + (f32x4){bflo(b.z), bfhi(b.z), bflo(b.w), bfhi(b.w)};
                    u32x4 w; w.x = cvt_pk_bf16(v0[0], v0[1]); w.y = cvt_pk_bf16(v0[2], v0[3]); w.z = cvt_pk_bf16(v1[0], v1[1]); w.w = cvt_pk_bf16(v1[2], v1[3]);
                    *(u32x4*)(xb + off + bj * HALF) = w;
                    const float r0 = bflo(w.x), r1 = bfhi(w.x), r2 = bflo(w.y), r3 = bfhi(w.y), r4 = bflo(w.z), r5 = bfhi(w.z), r6 = bflo(w.w), r7 = bfhi(w.w);
                    sq += ((r0 * r0 + r1 * r1) + (r2 * r2 + r3 * r3)) + ((r4 * r4 + r5 * r5) + (r6 * r6 + r7 * r7)); }
                sq += __shfl_xor(sq, 16); sq += __shfl_xor(sq, 32);
                if (fq == 0) part[(ai * HALF + wr * 64 + m * 16 + fr) * 4 + wc] = sq; }
        asm volatile("s_waitcnt lgkmcnt(0)" ::: "memory"); __builtin_amdgcn_s_barrier(); asm volatile("" ::: "memory");
        const int t = threadIdx.x;
        if (t < 256) { const f32x4 p = *(const LAS f32x4*)(part + t * 4); ssn[(size_t)(u.pm * BM + t) * 4 + u.pn] = (p.x + p.y) + (p.z + p.w); }
    }
};

struct EpiResFin {
    const bf16_t* xb; float* ssn; float* out; const float* gfin; unsigned* pcnt; LAS unsigned char* lds;
    __device__ __forceinline__ void operator()(f32x4 (&acc)[2][2][4][2], const Unit& u, int wr, int wc, int fr, int fq) const {
        const int row0 = u.pm * BM + wr * 64 + fr, col0 = u.pn * BM + wc * 32 + 8 * fq;
        LAS float* part = (LAS float*)(lds + PART_OFF); LAS float* rstab = part + 1024;
        u32x4 bb[2][4][2];
#pragma unroll
        for (int ai = 0; ai < 2; ++ai)
#pragma unroll
            for (int m = 0; m < 4; ++m)
#pragma unroll
                for (int bj = 0; bj < 2; ++bj) bb[ai][m][bj] = *(const u32x4*)(xb + (size_t)(row0 + ai * HALF + m * 16) * D + col0 + bj * HALF);
#pragma unroll
        for (int ai = 0; ai < 2; ++ai)
#pragma unroll
            for (int m = 0; m < 4; ++m) { float sq = 0.f;
#pragma unroll
                for (int bj = 0; bj < 2; ++bj) { const u32x4 b = bb[ai][m][bj];
                    const f32x4 v0 = acc[ai][bj][m][0] + (f32x4){bflo(b.x), bfhi(b.x), bflo(b.y), bfhi(b.y)}, v1 = acc[ai][bj][m][1] + (f32x4){bflo(b.z), bfhi(b.z), bflo(b.w), bfhi(b.w)};
                    acc[ai][bj][m][0] = v0; acc[ai][bj][m][1] = v1;
                    sq += ((v0[0] * v0[0] + v0[1] * v0[1]) + (v0[2] * v0[2] + v0[3] * v0[3])) + ((v1[0] * v1[0] + v1[1] * v1[1]) + (v1[2] * v1[2] + v1[3] * v1[3])); }
                sq += __shfl_xor(sq, 16); sq += __shfl_xor(sq, 32);
                if (fq == 0) part[(ai * HALF + wr * 64 + m * 16 + fr) * 4 + wc] = sq; }
        asm volatile("s_waitcnt lgkmcnt(0)" ::: "memory"); __builtin_amdgcn_s_barrier(); asm volatile("" ::: "memory");
        const int t = threadIdx.x;
        if (t < 256) { const f32x4 p = *(const LAS f32x4*)(part + t * 4); __hip_atomic_store(ssn + (size_t)(u.pm * BM + t) * 4 + u.pn, (p.x + p.y) + (p.z + p.w), __ATOMIC_RELAXED, __HIP_MEMORY_SCOPE_AGENT); }
        asm volatile("s_waitcnt vmcnt(0)" ::: "memory"); __builtin_amdgcn_s_barrier(); asm volatile("" ::: "memory");
        if (t == 0) { unsigned* c = pcnt + 8 * u.pm; (void)__hip_atomic_fetch_add(c, 1u, __ATOMIC_RELAXED, __HIP_MEMORY_SCOPE_AGENT);
            unsigned sp = 0; while (__hip_atomic_load(c, __ATOMIC_RELAXED, __HIP_MEMORY_SCOPE_AGENT) < 4u) { __builtin_amdgcn_s_sleep(1); if (++sp > (1u << 22)) break; }
            __builtin_amdgcn_fence(__ATOMIC_ACQUIRE, "agent"); asm volatile("s_waitcnt vmcnt(0)" ::: "memory"); }
        asm volatile("" ::: "memory"); __builtin_amdgcn_s_barrier(); asm volatile("" ::: "memory");
        if (t < 256) { const float* pp = ssn + (size_t)(u.pm * BM + t) * 4;
            const float p0 = __hip_atomic_load(pp, __ATOMIC_RELAXED, __HIP_MEMORY_SCOPE_AGENT), p1 = __hip_atomic_load(pp + 1, __ATOMIC_RELAXED, __HIP_MEMORY_SCOPE_AGENT),
                        p2 = __hip_atomic_load(pp + 2, __ATOMIC_RELAXED, __HIP_MEMORY_SCOPE_AGENT), p3 = __hip_atomic_load(pp + 3, __ATOMIC_RELAXED, __HIP_MEMORY_SCOPE_AGENT);
            rstab[t] = __builtin_amdgcn_rsqf(((p0 + p1) + (p2 + p3)) * (1.0f / D) + EPS); }
        asm volatile("s_waitcnt lgkmcnt(0)" ::: "memory"); __builtin_amdgcn_s_barrier(); asm volatile("" ::: "memory");
        f32x4 gg[2][2];
#pragma unroll
        for (int bj = 0; bj < 2; ++bj) { gg[bj][0] = *(const f32x4*)(gfin + col0 + bj * HALF); gg[bj][1] = *(const f32x4*)(gfin + col0 + bj * HALF + 4); }
#pragma unroll
        for (int ai = 0; ai < 2; ++ai)
#pragma unroll
            for (int m = 0; m < 4; ++m) { const int rl = ai * HALF + wr * 64 + m * 16 + fr; const float rs = rstab[rl]; float* orow = out + (size_t)(u.pm * BM + rl) * D + col0;
#pragma unroll
                for (int bj = 0; bj < 2; ++bj) { *(f32x4*)(orow + bj * HALF) = acc[ai][bj][m][0] * gg[bj][0] * rs; *(f32x4*)(orow + bj * HALF + 4) = acc[ai][bj][m][1] * gg[bj][1] * rs; } }
    }
};

template <class Epi, bool ALIGN_EPI>
__device__ __forceinline__ void gemm_phase(LAS unsigned char* lds, const Gemm g, const StaticOrder& S, const Epi& E) {
    int tid = threadIdx.x; asm volatile("" : "+v"(tid));
    const int wid = __builtin_amdgcn_readfirstlane(tid >> 6), lane = tid & 63, wr = wid >> 2, wc = wid & 3, fr = lane & 15, fq = lane >> 4;
    const int K = g.K, nt = K / BK, lda = g.lda;
    unsigned voffA[2], voffB[2];
#pragma unroll
    for (int i = 0; i < 2; ++i) { int R, C; stage_rc(tid * 16 + i * 8192, R, C); const int Rb = (R & ~31) + perm32(R & 31);
        voffA[i] = (unsigned)(R * lda + C) * 2u; voffB[i] = (unsigned)(Rb * K + C) * 2u; }
    const size_t kstep = (size_t)(BK * 2);
    const size_t hstepA = (size_t)HALF * lda * 2, hstepB = (size_t)HALF * K * 2;
    const size_t tstepA = 2 * hstepA, tstepB = 2 * hstepB;
    const unsigned ldsw = (unsigned)wid * 1024u;
    const unsigned ldsb = (unsigned)(unsigned long)lds + ldsw;
    const int aoff = lds_byte(wr * 64 + fr, fq * 8), boff = lds_byte(wc * 32 + fr, fq * 8);
#define PG8_SA(b, h) (((b) * 2 + (h)) * HTB)
#define PG8_SB(b, h) ((4 + (b) * 2 + (h)) * HTB)
#define PG8_STAGE(bufoff, gbase, voff) do { _Pragma("unroll") for (int _i = 0; _i < 2; ++_i) { \
        const unsigned _m0 = ldsb + (unsigned)((bufoff) + _i * 8192); const char* _gb = (const char*)(gbase); \
        asm volatile("s_mov_b32 m0, %0\n\ts_nop 0\n\tglobal_load_lds_dwordx4 %1, %2" :: "s"(_m0), "v"((voff)[_i]), "s"(_gb) : "m0", "memory"); } } while (0)
#define PG8_LDA(dst, b, h) do { _Pragma("unroll") for (int m = 0; m < 4; ++m) _Pragma("unroll") for (int k = 0; k < 2; ++k) dst[m][k] = *(const LAS bf16x8*)(lds + PG8_SA(b, h) + aoff + m * 2048 + k * 1024); } while (0)
#define PG8_LDB(dst, b, h) do { _Pragma("unroll") for (int n = 0; n < 2; ++n) _Pragma("unroll") for (int k = 0; k < 2; ++k) dst[n][k] = *(const LAS bf16x8*)(lds + PG8_SB(b, h) + boff + n * 2048 + k * 1024); } while (0)
#define PG8_MMA(ai, bj, At, Bt) do { __builtin_amdgcn_s_setprio(1); _Pragma("unroll") for (int m = 0; m < 4; ++m) _Pragma("unroll") for (int n = 0; n < 2; ++n) _Pragma("unroll") for (int k = 0; k < 2; ++k) \
        acc[ai][bj][m][n] = __builtin_amdgcn_mfma_f32_16x16x32_bf16(Bt[n][k], At[m][k], acc[ai][bj][m][n], 0, 0, 0); __builtin_amdgcn_s_setprio(0); } while (0)
#define PG8_WAIT_V(n) asm volatile("s_waitcnt vmcnt(" #n ")" ::: "memory")
#define PG8_WAIT_L(n) asm volatile("s_waitcnt lgkmcnt(" #n ")" ::: "memory")
#define PG8_BAR __builtin_amdgcn_s_barrier()
#define PG8_SCHED __builtin_amdgcn_sched_barrier(0)
    Unit cur, nxt; int ui = 0;
    if (!S.next(0, cur)) return;
    f32x4 acc[2][2][4][2];
#pragma unroll
    for (int a = 0; a < 2; ++a)
#pragma unroll
        for (int b = 0; b < 2; ++b)
#pragma unroll
            for (int m = 0; m < 4; ++m)
#pragma unroll
                for (int n = 0; n < 2; ++n) acc[a][b][m][n] = (f32x4){0.f, 0.f, 0.f, 0.f};
    bf16x8 At[4][2], B0[2][2], B1[2][2];
    const char* cA = (const char*)g.A + (size_t)cur.pm * tstepA + (size_t)cur.pn * g.a_pn_off * 2 + (size_t)(cur.pm >> 4) * g.a_adj; const char* cB = (const char*)g.Bt + (size_t)cur.pn * tstepB;
    PG8_STAGE(PG8_SB(0, 0), cB, voffB); PG8_STAGE(PG8_SB(0, 1), cB + hstepB, voffB); PG8_STAGE(PG8_SA(0, 0), cA, voffA); PG8_STAGE(PG8_SA(0, 1), cA + hstepA, voffA);
    if (wr == 1) PG8_BAR;
    PG8_WAIT_V(2); PG8_BAR;
    PG8_STAGE(PG8_SB(1, 0), cB + kstep, voffB); PG8_STAGE(PG8_SA(1, 0), cA + kstep, voffA); PG8_STAGE(PG8_SB(1, 1), cB + hstepB + kstep, voffB);
    PG8_WAIT_V(6); PG8_BAR;
    for (;;) {
        const bool has_next = S.next(ui + 1, nxt);
        const char* nA = has_next ? (const char*)g.A + (size_t)nxt.pm * tstepA + (size_t)nxt.pn * g.a_pn_off * 2 + (size_t)(nxt.pm >> 4) * g.a_adj : cA; const char* nB = has_next ? (const char*)g.Bt + (size_t)nxt.pn * tstepB : cB;
        for (int t = 0; t < nt; t += 2) {
            const bool last = (t == nt - 2);
            const char* a1 = cA + (size_t)(t + 1) * kstep;
            const char* a2 = last ? nA : cA + (size_t)(t + 2) * kstep; const char* b2 = last ? nB : cB + (size_t)(t + 2) * kstep;
            const char* a3 = a2 + kstep; const char* b3 = b2 + kstep;
            PG8_LDB(B0, 0, 0); PG8_LDB(B1, 0, 1); PG8_SCHED; PG8_LDA(At, 0, 0); PG8_STAGE(PG8_SA(1, 1), a1 + hstepA, voffA);
            PG8_WAIT_V(8); PG8_WAIT_L(0); PG8_BAR; PG8_MMA(0, 0, At, B0); PG8_MMA(0, 1, At, B1); PG8_BAR; PG8_SCHED;
            PG8_LDA(At, 0, 1); PG8_STAGE(PG8_SB(0, 0), b2, voffB); PG8_STAGE(PG8_SB(0, 1), b2 + hstepB, voffB); PG8_STAGE(PG8_SA(0, 0), a2, voffA);
            PG8_WAIT_V(8); PG8_WAIT_L(0); PG8_BAR; PG8_MMA(1, 0, At, B0); PG8_MMA(1, 1, At, B1); PG8_BAR; PG8_SCHED;
            PG8_LDB(B0, 1, 0); PG8_LDB(B1, 1, 1); PG8_SCHED; PG8_LDA(At, 1, 0); PG8_STAGE(PG8_SA(0, 1), a2 + hstepA, voffA);
            PG8_WAIT_V(8); PG8_WAIT_L(0); PG8_BAR; PG8_MMA(0, 0, At, B0); PG8_MMA(0, 1, At, B1); PG8_BAR; PG8_SCHED;
            PG8_LDA(At, 1, 1); PG8_STAGE(PG8_SB(1, 0), b3, voffB); PG8_STAGE(PG8_SB(1, 1), b3 + hstepB, voffB); PG8_STAGE(PG8_SA(1, 0), a3, voffA);
            PG8_WAIT_V(8); PG8_WAIT_L(0); PG8_BAR; PG8_MMA(1, 0, At, B0); PG8_MMA(1, 1, At, B1); PG8_BAR; PG8_SCHED;
        }
        if constexpr (ALIGN_EPI) { if (wr == 0) PG8_BAR; }
        E(acc, cur, wr, wc, fr, fq);
        if (!has_next) break;
#pragma unroll
        for (int a = 0; a < 2; ++a)
#pragma unroll
            for (int b = 0; b < 2; ++b)
#pragma unroll
                for (int m = 0; m < 4; ++m)
#pragma unroll
                    for (int n = 0; n < 2; ++n) acc[a][b][m][n] = (f32x4){0.f, 0.f, 0.f, 0.f};
        cur = nxt; cA = nA; cB = nB; ++ui;
        if constexpr (ALIGN_EPI) { if (wr == 1) PG8_BAR; }
    }
    PG8_WAIT_V(0);
    if constexpr (!ALIGN_EPI) { if (wr == 0) PG8_BAR; }
    PG8_BAR;
#undef PG8_SA
#undef PG8_SB
#undef PG8_STAGE
#undef PG8_LDA
#undef PG8_LDB
#undef PG8_MMA
#undef PG8_WAIT_V
#undef PG8_WAIT_L
#undef PG8_BAR
#undef PG8_SCHED
}
}

#define LDS_WAIT() asm volatile("s_waitcnt lgkmcnt(0)" ::: "memory")
__device__ __forceinline__ unsigned f2bf(float f) { unsigned u = __builtin_bit_cast(unsigned, f); return (u + 0x7fffu + ((u >> 16) & 1u)) >> 16; }
__device__ __forceinline__ unsigned pk2(float lo, float hi) { return pg8::cvt_pk_bf16(lo, hi); }
__device__ __forceinline__ float wave_sum(float v) {
#pragma unroll
    for (int o = 1; o < 64; o <<= 1) v += __shfl_xor(v, o);
    return v;
}

__device__ __forceinline__ int tid_opaque() { int t = threadIdx.x; asm volatile("" : "+v"(t)); return t; }
__device__ __forceinline__ int sgpr_opaque(int x) { asm volatile("" : "+s"(x)); return x; }
struct Args { const float* in[19]; float* out; unsigned char* ws; int ph_lo, ph_hi; };
constexpr int TBL_OFF = 131072 + 1024;
struct PT { LAS unsigned long long* tbl; };
__device__ __forceinline__ unsigned long long ldp(const PT& T, int i) {
    const unsigned long long v = T.tbl[i]; const unsigned lo = __builtin_amdgcn_readfirstlane((unsigned)v), hi = __builtin_amdgcn_readfirstlane((unsigned)(v >> 32));
    return ((unsigned long long)hi << 32) | lo; }
#define INP(i) ((const float*)ldp(T, (i)))
#define OUTP ((float*)ldp(T, 19))
#define WSP ((unsigned char*)ldp(T, 20))

__device__ __forceinline__ void tr_item(const float* W, int ldn, int N, bf16_t* WT, int ldk, const float* gain, int rbase, int rstride, LAS float* scr, int item, int lane) {
    const int nblk = N / 32, kb = item / nblk, nb = item % nblk, k0 = 64 * kb, n0 = 32 * nb;
    f32x4 v[8]; float gk[8];
#pragma unroll
    for (int i = 0; i < 8; ++i) { const int kk = 8 * i + (lane >> 3); v[i] = *(const f32x4*)(W + (size_t)(k0 + kk) * ldn + n0 + 4 * (lane & 7)); gk[i] = gain ? gain[k0 + kk] : 1.0f; }
#pragma unroll
    for (int i = 0; i < 8; ++i) { LAS float* d = scr + (8 * i + (lane >> 3)) * 33 + 4 * (lane & 7); d[0] = v[i].x * gk[i]; d[1] = v[i].y * gk[i]; d[2] = v[i].z * gk[i]; d[3] = v[i].w * gk[i]; }
    LDS_WAIT(); asm volatile("" ::: "memory");
    const int c = lane & 7;
#pragma unroll
    for (int j = 0; j < 4; ++j) { const int n = (lane >> 3) + 8 * j; const LAS float* s = scr + (8 * c) * 33 + n;
        u32x4 o; o.x = pk2(s[0 * 33], s[1 * 33]); o.y = pk2(s[2 * 33], s[3 * 33]); o.z = pk2(s[4 * 33], s[5 * 33]); o.w = pk2(s[6 * 33], s[7 * 33]);
        const int nn = n0 + n, dest = rbase + (nn >> 7) * rstride + (nn & 127);
        *(u32x4*)(WT + (size_t)dest * ldk + k0 + 8 * c) = o; }
    LDS_WAIT(); asm volatile("" ::: "memory");
}

__device__ __forceinline__ void prep_phase(const PT& T, LAS unsigned char* lds) {
    const int tid = tid_opaque(), lane = tid & 63, wave = __builtin_amdgcn_readfirstlane(tid >> 6);
    const int G = sgpr_opaque(gridDim.x), bid = sgpr_opaque(blockIdx.x), gw = bid * NWAVES + wave, NGW = G * NWAVES;
    LAS float* scr = (LAS float*)(lds + wave * 16384);
    bf16_t* Wb = (bf16_t*)(WSP + WS_W);
    constexpr int I_1Kx1K = (D / 64) * (D / 32), I_1Kx2K = (D / 64) * (2048 / 32), I_GRP = (256 / 64) * (256 / 32), I_UP = (D / 64) * (FH / 32), I_DN = (FH / 64) * (D / 32);
    constexpr int NITEMS = 2 * (I_1Kx2K + I_1Kx1K) + 4 * I_1Kx1K + 2 * I_1Kx1K + 4 * I_GRP + 4 * (2 * I_UP + I_DN);
    for (int it = gw; it < NITEMS; it += NGW) {
        int r = it;
#define TRJ(cnt, W, ldn, N, WT, ldk, gain, rbase, rstride) if (r >= 0) { if (r < (cnt)) { tr_item((W), (ldn), (N), (WT), (ldk), (gain), (rbase), (rstride), scr, r, lane); r = -1; } else r -= (cnt); }
        TRJ(I_1Kx2K, INP(4), 2048, 2048, Wb + WO_A_IN0, D, INP(1) + 0 * D, 0, 128)
        TRJ(I_1Kx1K, INP(8), D, D, Wb + WO_A_OUT0, D, nullptr, 0, 128)
        TRJ(I_1Kx2K, INP(4) + (size_t)D * 2048, 2048, 2048, Wb + WO_A_STRIDE + WO_A_IN0, D, INP(1) + 3 * D, 0, 128)
        TRJ(I_1Kx1K, INP(8) + (size_t)D * D, D, D, Wb + WO_A_STRIDE + WO_A_OUT0, D, nullptr, 0, 128)
        TRJ(I_1Kx1K, INP(9), 3 * D, D, Wb + WO_B_B, D, INP(1) + 1 * D, 0, 128)
        TRJ(I_1Kx1K, INP(9) + D, 3 * D, D, Wb + WO_B_CX, D, INP(1) + 1 * D, 0, 256)
        TRJ(I_1Kx1K, INP(9) + 2 * D, 3 * D, D, Wb + WO_B_CX, D, INP(1) + 1 * D, 128, 256)
        TRJ(I_1Kx1K, INP(11), D, D, Wb + WO_B_OUT, D, nullptr, 0, 128)
        TRJ(I_1Kx1K, INP(12), D, D, Wb + WO_C_IN, D, INP(1) + 2 * D, 0, 128)
        TRJ(I_1Kx1K, INP(15), D, D, Wb + WO_C_OUT, D, nullptr, 0, 128)
        TRJ(I_GRP, INP(13) + 0 * 65536, 256, 256, Wb + WO_C_GRP + 0 * 65536, 256, nullptr, 0, 128)
        TRJ(I_GRP, INP(13) + 1 * 65536, 256, 256, Wb + WO_C_GRP + 1 * 65536, 256, nullptr, 0, 128)
        TRJ(I_GRP, INP(13) + 2 * 65536, 256, 256, Wb + WO_C_GRP + 2 * 65536, 256, nullptr, 0, 128)
        TRJ(I_GRP, INP(13) + 3 * 65536, 256, 256, Wb + WO_C_GRP + 3 * 65536, 256, nullptr, 0, 128)
#pragma unroll
        for (int l = 0; l < 4; ++l) {
            TRJ(I_UP, INP(16) + (size_t)l * D * FH, FH, FH, Wb + WO_F_GU0 + l * WO_F_STRIDE, D, INP(2) + l * D, 0, 256)
            TRJ(I_UP, INP(17) + (size_t)l * D * FH, FH, FH, Wb + WO_F_GU0 + l * WO_F_STRIDE, D, INP(2) + l * D, 128, 256)
            TRJ(I_DN, INP(18) + (size_t)l * D * FH, D, D, Wb + WO_F_D0 + l * WO_F_STRIDE, FH, nullptr, 0, 128)
        }
#undef TRJ
    }
    const float* wsp6 = INP(6);
    for (int idx = bid * NTHR + tid; idx < 2 * 8 * 128 * 128; idx += G * NTHR) {
        const int i = (idx >> 7) & 127, j = idx & 127; const float w = wsp6[idx];
        (Wb + WO_A_S0 + (size_t)(idx >> 17) * WO_A_STRIDE)[idx & 131071] = (bf16_t)f2bf((i < 64 && j >= 64) ? 0.f : w);
    }
    bf16_t* XB = (bf16_t*)(WSP + WS_XB); float* ss0 = (float*)(WSP + WS_CTL);
    const float* xin = INP(0);
    for (int m = 4 * gw; m < M; m += 4 * NGW) {
        f32x4 v[4][4];
#pragma unroll
        for (int r = 0; r < 4; ++r)
#pragma unroll
            for (int j = 0; j < 4; ++j) v[r][j] = ((const f32x4*)(xin + (size_t)(m + r) * D) + lane)[64 * j];
#pragma unroll
        for (int r = 0; r < 4; ++r) { u32x2* o8 = (u32x2*)(XB + (size_t)(m + r) * D) + lane; float sq = 0.f;
#pragma unroll
            for (int j = 0; j < 4; ++j) { u32x2 w; w.x = pk2(v[r][j].x, v[r][j].y); w.y = pk2(v[r][j].z, v[r][j].w); o8[64 * j] = w;
                const float r0 = bflo(w.x), r1 = bfhi(w.x), r2 = bflo(w.y), r3 = bfhi(w.y); sq += (r0 * r0 + r1 * r1) + (r2 * r2 + r3 * r3); }
            sq = wave_sum(sq); if (lane == 0) *(f32x4*)(ss0 + 4 * (size_t)(m + r)) = (f32x4){sq, 0.f, 0.f, 0.f}; }
    }
}

__device__ __forceinline__ void spatial_phase(const PT& T, int a, LAS unsigned char* lds, int vc) {
    const int tid = tid_opaque(), lane = tid & 63, wid = __builtin_amdgcn_readfirstlane(tid >> 6), fr = lane & 15, fq = lane >> 4;
    const bf16_t* __restrict__ Z = (const bf16_t*)((unsigned char*)OUTP); bf16_t* __restrict__ Y = (bf16_t*)(WSP + WS_T2);
    const float* __restrict__ vst = (const float*)(WSP + WS_VST + (size_t)a * MiB);
    const float* __restrict__ gv = INP(5) + a * D; const float* __restrict__ bs = INP(7) + a * D;
    const bf16_t* __restrict__ Wm = (const bf16_t*)(WSP + WS_W) + WO_A_S0 + (size_t)a * WO_A_STRIDE;
    constexpr int LDW = 136;
    LAS bf16_t* sW = (LAS bf16_t*)lds; LAS bf16_t* sV = (LAS bf16_t*)(lds + 128 * LDW * 2);
    const int R8 = sgpr_opaque(gridDim.x) >> 3, vx = sgpr_opaque(vc) & 7, vr = sgpr_opaque(vc) >> 3;
    const int wi = wid >> 2, wc = wid & 3, ib = wi * 64, cb = wc * 32;
    const int jq = tid >> 4, c8 = (tid & 15) * 8;
    for (int ti = vr; ti < 256; ti += R8) {
        const int t = 256 * vx + ti, nb = t >> 3, g = t & 7;
        u32x4 wreg[4], vreg[4]; f32x4 p1[4], p2[4];
#pragma unroll
        for (int q = 0; q < 4; ++q) { const int j = jq + 32 * q; const size_t row = (size_t)nb * 128 + j;
            wreg[q] = *(const u32x4*)(Wm + (size_t)g * 16384 + j * 128 + c8);
            vreg[q] = *(const u32x4*)(Z + row * 2048 + 1024 + g * 128 + c8);
            p1[q] = *(const f32x4*)(vst + 8 * row); p2[q] = *(const f32x4*)(vst + 8 * row + 4); }
        const f32x4 g0 = *(const f32x4*)(gv + g * 128 + c8), g1 = *(const f32x4*)(gv + g * 128 + c8 + 4);
#pragma unroll
        for (int q = 0; q < 4; ++q) { const int j = jq + 32 * q;
            const float s1 = (p1[q].x + p1[q].y) + (p1[q].z + p1[q].w), s2 = (p2[q].x + p2[q].y) + (p2[q].z + p2[q].w);
            const float mu = s1 * (1.0f / D); float var = s2 * (1.0f / D) - mu * mu; var = var > 0.f ? var : 0.f; const float rs = __builtin_amdgcn_rsqf(var + EPS);
            const u32x4 raw = vreg[q];
            u32x4 o; o.x = pk2((bflo(raw.x) - mu) * rs * g0.x, (bfhi(raw.x) - mu) * rs * g0.y); o.y = pk2((bflo(raw.y) - mu) * rs * g0.z, (bfhi(raw.y) - mu) * rs * g0.w);
            o.z = pk2((bflo(raw.z) - mu) * rs * g1.x, (bfhi(raw.z) - mu) * rs * g1.y); o.w = pk2((bflo(raw.w) - mu) * rs * g1.z, (bfhi(raw.w) - mu) * rs * g1.w);
            *(LAS u32x4*)(sV + j * LDW + c8) = o; *(LAS u32x4*)(sW + j * LDW + c8) = wreg[q]; }
        u32x2 uu[4][2]; float bsv[4];
#pragma unroll
        for (int mt = 0; mt < 4; ++mt) { const int i = ib + 16 * mt + fr; bsv[mt] = bs[g * 128 + i];
#pragma unroll
            for (int n = 0; n < 2; ++n) uu[mt][n] = *(const u32x2*)(Z + ((size_t)nb * 128 + i) * 2048 + g * 128 + cb + 16 * n + 4 * fq); }
        __syncthreads();
        f32x4 acc[4][2];
#pragma unroll
        for (int mt = 0; mt < 4; ++mt)
#pragma unroll
            for (int n = 0; n < 2; ++n) acc[mt][n] = (f32x4){0.f, 0.f, 0.f, 0.f};
        const int nk = wi == 0 ? 2 : 4;
        for (int kk = 0; kk < nk; ++kk) {
            bf16x8 bfr[4], af[2];
#pragma unroll
            for (int mt = 0; mt < 4; ++mt) bfr[mt] = *(const LAS bf16x8*)(sW + (ib + 16 * mt + fr) * LDW + kk * 32 + 8 * fq);
#pragma unroll
            for (int n = 0; n < 2; ++n)
#pragma unroll
                for (int e = 0; e < 8; ++e) af[n][e] = (short)sV[(kk * 32 + 8 * fq + e) * LDW + cb + 16 * n + fr];
#pragma unroll
            for (int mt = 0; mt < 4; ++mt)
#pragma unroll
                for (int n = 0; n < 2; ++n) acc[mt][n] = __builtin_amdgcn_mfma_f32_16x16x32_bf16(af[n], bfr[mt], acc[mt][n], 0, 0, 0);
        }
#pragma unroll
        for (int mt = 0; mt < 4; ++mt) { const int i = ib + 16 * mt + fr; const size_t row = (size_t)nb * 128 + i;
#pragma unroll
            for (int n = 0; n < 2; ++n) { const int c = g * 128 + cb + 16 * n + 4 * fq; const u32x2 u2 = uu[mt][n];
                u32x2 o; o.x = pk2(bflo(u2.x) * (acc[mt][n][0] + bsv[mt]), bfhi(u2.x) * (acc[mt][n][1] + bsv[mt])); o.y = pk2(bflo(u2.y) * (acc[mt][n][2] + bsv[mt]), bfhi(u2.y) * (acc[mt][n][3] + bsv[mt]));
                *(u32x2*)(Y + row * D + c) = o; } }
        __syncthreads();
    }
}

__device__ __forceinline__ void conv_phase(const PT& T, int vc) {
    const int tid = tid_opaque(), chunk = tid & 127, c8 = chunk * 8, rsub = tid >> 7, R8 = sgpr_opaque(gridDim.x) >> 3, vx = sgpr_opaque(vc) & 7, vr = sgpr_opaque(vc) >> 3;
    const bf16_t* __restrict__ Q = (const bf16_t*)((unsigned char*)OUTP) + (size_t)vx * CHUNK_ADJ; const bf16_t* __restrict__ Bg = Q + CHUNK_ADJ; bf16_t* __restrict__ YB = (bf16_t*)(WSP + WS_T2);
    float w[3][8];
#pragma unroll
    for (int k = 0; k < 3; ++k) { const f32x4 a = *(const f32x4*)(INP(10) + k * D + c8), b = *(const f32x4*)(INP(10) + k * D + c8 + 4);
        w[k][0] = a.x; w[k][1] = a.y; w[k][2] = a.z; w[k][3] = a.w; w[k][4] = b.x; w[k][5] = b.y; w[k][6] = b.z; w[k][7] = b.w; }
    for (int ri = vr * 4 + rsub; ri < 512; ri += R8 * 4) {
        const int run = 512 * vx + ri, r0 = run * 8, tt0 = r0 & (SEQ - 1);
        u32x4 q[10], b[8];
        q[0] = (u32x4){0u, 0u, 0u, 0u}; q[1] = q[0];
        if (tt0 >= 2) { q[0] = *(const u32x4*)(Q + (size_t)(r0 - 2) * D + c8); q[1] = *(const u32x4*)(Q + (size_t)(r0 - 1) * D + c8); }
#pragma unroll
        for (int i = 0; i < 8; ++i) { const size_t off = (size_t)(r0 + i) * D + c8; q[2 + i] = *(const u32x4*)(Q + off); b[i] = *(const u32x4*)(Bg + off); }
#pragma unroll
        for (int i = 0; i < 8; ++i) { const u32x4 q0 = q[i], q1 = q[i + 1], q2 = q[i + 2], bb = b[i]; u32x4 o;
#define CV(e, qa, qb, qc, bv, LOHI) (LOHI(bv) * (w[0][e] * LOHI(qa) + w[1][e] * LOHI(qb) + w[2][e] * LOHI(qc)))
            o.x = pk2(CV(0, q0.x, q1.x, q2.x, bb.x, bflo), CV(1, q0.x, q1.x, q2.x, bb.x, bfhi)); o.y = pk2(CV(2, q0.y, q1.y, q2.y, bb.y, bflo), CV(3, q0.y, q1.y, q2.y, bb.y, bfhi));
            o.z = pk2(CV(4, q0.z, q1.z, q2.z, bb.z, bflo), CV(5, q0.z, q1.z, q2.z, bb.z, bfhi)); o.w = pk2(CV(6, q0.w, q1.w, q2.w, bb.w, bflo), CV(7, q0.w, q1.w, q2.w, bb.w, bfhi));
#undef CV
            *(u32x4*)(YB + (size_t)(r0 + i) * D + c8) = o; }
    }
}

template <int W>
__device__ __forceinline__ void pool_run(const bf16_t* __restrict__ Pp, bf16_t* __restrict__ Dp, int r0, int tt0, int c8) {
    u32x4 v[W - 1 + 8];
#pragma unroll
    for (int k = 0; k < W - 1; ++k) v[k] = (tt0 - (W - 1) + k >= 0) ? *(const u32x4*)(Pp + (size_t)(r0 - (W - 1) + k) * D + c8) : (u32x4){0u, 0u, 0u, 0u};
#pragma unroll
    for (int i = 0; i < 8; ++i) v[W - 1 + i] = *(const u32x4*)(Pp + (size_t)(r0 + i) * D + c8);
    float s[8];
#pragma unroll
    for (int e = 0; e < 8; ++e) s[e] = 0.f;
#pragma unroll
    for (int k = 0; k < W - 1; ++k) { s[0] += bflo(v[k].x); s[1] += bfhi(v[k].x); s[2] += bflo(v[k].y); s[3] += bfhi(v[k].y); s[4] += bflo(v[k].z); s[5] += bfhi(v[k].z); s[6] += bflo(v[k].w); s[7] += bfhi(v[k].w); }
#pragma unroll
    for (int i = 0; i < 8; ++i) { const int tt = tt0 + i; const u32x4 x = v[W - 1 + i];
        const float p[8] = {bflo(x.x), bfhi(x.x), bflo(x.y), bfhi(x.y), bflo(x.z), bfhi(x.z), bflo(x.w), bfhi(x.w)};
#pragma unroll
        for (int e = 0; e < 8; ++e) s[e] += p[e];
        const int cnt = (tt + 1) < W ? (tt + 1) : W; const float inv = 1.0f / (float)cnt;
        u32x4 o; o.x = pk2(s[0] * inv - p[0], s[1] * inv - p[1]); o.y = pk2(s[2] * inv - p[2], s[3] * inv - p[3]); o.z = pk2(s[4] * inv - p[4], s[5] * inv - p[5]); o.w = pk2(s[6] * inv - p[6], s[7] * inv - p[7]);
        *(u32x4*)(Dp + (size_t)(r0 + i) * D + c8) = o;
        const u32x4 y = v[i];
        s[0] -= bflo(y.x); s[1] -= bfhi(y.x); s[2] -= bflo(y.y); s[3] -= bfhi(y.y); s[4] -= bflo(y.z); s[5] -= bfhi(y.z); s[6] -= bflo(y.w); s[7] -= bfhi(y.w); }
}
__device__ __forceinline__ void pool_phase(const PT& T, int vc) {
    const int tid = tid_opaque(), lane = tid & 63, wave = __builtin_amdgcn_readfirstlane(tid >> 6), R8 = sgpr_opaque(gridDim.x) >> 3, vx = sgpr_opaque(vc) & 7, vr = sgpr_opaque(vc) >> 3;
    const int g = wave & 3, c8 = (g * 32 + (lane & 31)) * 8, rsel = (wave >> 2) * 2 + (lane >> 5);
    const bf16_t* __restrict__ Pp = (const bf16_t*)((unsigned char*)OUTP) + (size_t)vx * CHUNK_ADJ; bf16_t* __restrict__ Dp = (bf16_t*)(WSP + WS_T2);
    for (int ri = vr * 4 + rsel; ri < 512; ri += R8 * 4) {
        const int run = 512 * vx + ri, r0 = run * 8, tt0 = r0 & (SEQ - 1);
        if (g == 0) pool_run<2>(Pp, Dp, r0, tt0, c8); else if (g == 1) pool_run<4>(Pp, Dp, r0, tt0, c8); else if (g == 2) pool_run<8>(Pp, Dp, r0, tt0, c8); else pool_run<16>(Pp, Dp, r0, tt0, c8);
    }
}

__device__ __forceinline__ void final_phase(const PT& T, int vc) {
    const int tid = tid_opaque(), lane = tid & 63, wave = tid >> 6, R8 = sgpr_opaque(gridDim.x) >> 3, vx = sgpr_opaque(vc) & 7, vr = sgpr_opaque(vc) >> 3;
    const float* ss = (const float*)(WSP + WS_CTL) + (size_t)8 * M * 4; const f32x4* gp = (const f32x4*)INP(3) + lane;
    f32x4 gg[4];
#pragma unroll
    for (int j = 0; j < 4; ++j) gg[j] = gp[64 * j];
    const bf16_t* XB = (const bf16_t*)(WSP + WS_XB); float* outp = OUTP;
    for (int mi = vr * NWAVES + wave; mi < 4096; mi += R8 * NWAVES) { const int m = 4096 * vx + mi; const float rs = pg8::rstd_of(ss, m); const u32x2* xr = (const u32x2*)(XB + (size_t)m * D) + lane; f32x4* orow = (f32x4*)(outp + (size_t)m * D) + lane;
#pragma unroll
        for (int j = 0; j < 4; ++j) { const u32x2 b = xr[64 * j]; orow[64 * j] = (f32x4){bflo(b.x), bfhi(b.x), bflo(b.y), bfhi(b.y)} * gg[j] * rs; } }
}

#define XB_TMO      128
#define XB_XCNT(j)  (256  + 64 * (j))
#define XB_XSUB(j)  (1280 + 64 * (j))
#define XB_XGEN(j)  (2304 + 64 * (j))
#define XB_TOP      3328
#define XB_TOPGEN   3392
#define XCD_BAR_WORDS 3456
#define XB_SPIN_CAP (1u << 18)
__device__ __forceinline__ unsigned xb_ld(unsigned* p)              { return __hip_atomic_load(p, __ATOMIC_RELAXED, __HIP_MEMORY_SCOPE_AGENT); }
__device__ __forceinline__ unsigned xb_add(unsigned* p, unsigned v) { return __hip_atomic_fetch_add(p, v, __ATOMIC_RELAXED, __HIP_MEMORY_SCOPE_AGENT); }
__device__ __forceinline__ unsigned xb_xcc_id() { return (unsigned)__builtin_amdgcn_s_getreg((3 << 11) | 20) & 0xFu; }
#define XB_SPIN(cond, bar) do { unsigned _sp = 0; while (cond) { __builtin_amdgcn_s_sleep(1); \
    if ((++_sp & 255u) == 0u) { if (xb_ld(&(bar)[XB_TMO])) break; if (_sp > XB_SPIN_CAP) { atomicAdd(&(bar)[XB_TMO], 1u); break; } } } } while (0)
#define XL_SUB(j)   (4096 + 64 * (j))
#define XL_GEN(j)   (5120 + 64 * (j))
#define XL_RANK(j)  (6144 + 64 * (j))
#define XL_PCNT     7168
__device__ __forceinline__ void xcc_barrier(unsigned* bar, unsigned x, unsigned nloc) {
    asm volatile("s_waitcnt vmcnt(0)" ::: "memory");
    __syncthreads();
    if (threadIdx.x == 0) {
        __builtin_amdgcn_s_waitcnt(0);
        const unsigned old = xb_add(&bar[XL_SUB(x)], 1u), gen = old / nloc;
        if (old + 1u == (gen + 1u) * nloc) xb_add(&bar[XL_GEN(x)], 1u); else XB_SPIN(xb_ld(&bar[XL_GEN(x)]) == gen, bar);
        __builtin_amdgcn_fence(__ATOMIC_ACQUIRE, "agent");
        asm volatile("s_waitcnt vmcnt(0)" ::: "memory");
    }
    __syncthreads();
}
__device__ __forceinline__ void xcd_barrier_post(unsigned* bar) { if (threadIdx.x == 0) (void)xb_add(&bar[XB_XCNT(xb_xcc_id())], 1u); }
__device__ __forceinline__ void xcd_barrier_complete(unsigned* bar, unsigned x, unsigned& nloc, unsigned& nx) {
    const unsigned G = gridDim.x * gridDim.y * gridDim.z;
    unsigned sum, cnt, mine, sp = 0u;
    for (;;) {
        sum = 0u; cnt = 0u; mine = 0u;
#pragma unroll
        for (unsigned j = 0; j < 16; ++j) { const unsigned c = xb_ld(&bar[XB_XCNT(j)]); sum += c; cnt += (c > 0u) ? 1u : 0u; mine = (j == x) ? c : mine; }
        if (sum == G) break;
        __builtin_amdgcn_s_sleep(1);
        if ((++sp & 255u) == 0u) { if (xb_ld(&bar[XB_TMO])) break; if (sp > XB_SPIN_CAP) { atomicAdd(&bar[XB_TMO], 1u); break; } }
    }
    nloc = mine > 0u ? mine : 1u; nx = cnt > 0u ? cnt : 1u;
}
__device__ __forceinline__ void xcd_barrier(unsigned* bar, volatile LAS unsigned* st) {
    asm volatile("s_waitcnt vmcnt(0)" ::: "memory");
    __syncthreads();
    if (threadIdx.x == 0) {
        const unsigned x = xb_xcc_id();
        __builtin_amdgcn_s_waitcnt(0);
        unsigned nloc = st[0], nx = st[1];
        if (nloc == 0u) { xcd_barrier_complete(bar, x, nloc, nx); st[0] = nloc; st[1] = nx; }
        const unsigned old = xb_add(&bar[XB_XSUB(x)], 1u);
        const unsigned gen = old / nloc;
        if (old + 1u == (gen + 1u) * nloc) {
            __builtin_amdgcn_fence(__ATOMIC_RELEASE, "agent");
            asm volatile("s_waitcnt vmcnt(0)" ::: "memory");
            const unsigned og = xb_add(&bar[XB_TOP], 1u);
            const unsigned tg = og / nx;
            if (og + 1u == (tg + 1u) * nx) xb_add(&bar[XB_TOPGEN], 1u);
            else XB_SPIN(xb_ld(&bar[XB_TOPGEN]) == tg, bar);
            __builtin_amdgcn_fence(__ATOMIC_ACQUIRE, "agent");
            xb_add(&bar[XB_XGEN(x)], 1u);
            asm volatile("s_waitcnt vmcnt(0)" ::: "memory");
        } else {
            XB_SPIN(xb_ld(&bar[XB_XGEN(x)]) == gen, bar);
            __builtin_amdgcn_fence(__ATOMIC_ACQUIRE, "agent");
            asm volatile("s_waitcnt vmcnt(0)" ::: "memory");
        }
    }
    __syncthreads();
}

constexpr int NPH = 30;
#ifndef REP_MASK
#define REP_MASK 0u
#endif
__global__ void __launch_bounds__(NTHR, 2) fwd_megakernel(Args P) {
    extern __shared__ __attribute__((aligned(16))) unsigned char lds_raw[];
    LAS unsigned char* lds = (LAS unsigned char*)lds_raw;
    cg::grid_group grid = cg::this_grid();
    PT T; T.tbl = (LAS unsigned long long*)(lds + TBL_OFF);
    if (threadIdx.x == 0) {
#pragma unroll
        for (int i = 0; i < 19; ++i) T.tbl[i] = (unsigned long long)P.in[i];
        T.tbl[19] = (unsigned long long)P.out; T.tbl[20] = (unsigned long long)P.ws;
    }
    volatile LAS unsigned* bst = (volatile LAS unsigned*)(lds + 131072 + 16);
    if (threadIdx.x < 2) bst[threadIdx.x] = 0u;
    __syncthreads();
    xcd_barrier_post((unsigned*)(P.ws + WS_BAR));
    if (threadIdx.x == 0) { unsigned* bar0 = (unsigned*)(P.ws + WS_BAR); const unsigned xc = xb_xcc_id(); bst[2] = xc; bst[3] = xb_add(&bar0[XL_RANK(xc)], 1u); }
    int nsync = 0, vc = blockIdx.x, teams = 0;
    bool pending = false;
    const int ph_hi = P.ph_hi;
    for (int ph2 = 2 * P.ph_lo; ph2 < 2 * ph_hi; ++ph2) {
        const int ph = ph2 >> 1;
        if (ph2 & 1) { const int s_ = (ph - 1) % 7; const bool rep = (ph == 0) ? ((REP_MASK >> 8) & 1u) : (ph < NPH - 1 && ((REP_MASK >> s_) & 1u) && s_ != 6 && s_ != 4); if (!rep) continue; }
        const int L = (ph - 1) / 7, s = (ph - 1) % 7, kind = L % 3, a = L / 3;
        bool run = true;
        if (ph > 0 && ph < NPH - 1) { if (s == 1 && kind != 1) run = false; if (s == 3 && kind != 2) run = false; }
        if (ph == NPH - 1 && teams) continue;
        if (!run) continue;
        if (pending && !(ph > 0 && ph < NPH - 1 && s == 1)) {
            const bool gseam = nsync == 0 || !teams;
            if (P.ph_lo < 0) grid.sync(); else if (gseam) xcd_barrier((unsigned*)(WSP + WS_BAR), bst); else xcc_barrier((unsigned*)(WSP + WS_BAR), (unsigned)(vc & 7), gridDim.x >> 3);
            if (nsync == 0) {
                if (threadIdx.x == 0) { unsigned* bar0 = (unsigned*)(WSP + WS_BAR); const unsigned want = gridDim.x >> 3; unsigned okc = (gridDim.x & 7u) == 0u;
#pragma unroll
                    for (unsigned j = 0; j < 16; ++j) { const unsigned cj = xb_ld(&bar0[XL_RANK(j)]); okc &= (j < 8 ? cj == want : cj == 0u); }
                    bst[4] = okc; }
                __syncthreads();
                teams = __builtin_amdgcn_readfirstlane((int)bst[4]);
                if (teams) vc = (__builtin_amdgcn_readfirstlane((int)bst[3]) << 3) | __builtin_amdgcn_readfirstlane((int)bst[2]);
            }
            ++nsync; }
        pending = true;
        asm volatile("" ::: "memory");
        if (ph == 0) { prep_phase(T, lds); __syncthreads(); continue; }
        if (ph == NPH - 1) { final_phase(T, vc); continue; }
        if (s == 2) { if (kind == 0) spatial_phase(T, a, lds, vc); else if (kind == 1) conv_phase(T, vc); else pool_phase(T, vc); __syncthreads(); continue; }
        const int G = sgpr_opaque(gridDim.x), bidx = sgpr_opaque(vc);
        unsigned char* ws = WSP;
        const bf16_t* Wb = (const bf16_t*)(ws + WS_W);
        bf16_t* XB = (bf16_t*)(ws + WS_XB); bf16_t* H = (bf16_t*)(ws + WS_H); bf16_t* T1 = (bf16_t*)OUTP; bf16_t* T2 = (bf16_t*)(ws + WS_T2);
        float* ssb = (float*)(ws + WS_CTL);
        const float* ss_mix = ssb + (size_t)(2 * L) * M * 4; float* ss_ffn = ssb + (size_t)(2 * L + 1) * M * 4; float* ss_next = ssb + (size_t)(2 * L + 2) * M * 4;
        pg8::StaticOrder S;
        if (s == 0 && kind == 0) {
            pg8::Gemm g{XB, Wb + WO_A_IN0 + (size_t)a * WO_A_STRIDE, M, 2048, D, D, 0, 0u}; S.init(M, 2048, G, bidx);
            pg8::EpiGeluStats E{T1, 2048, ss_mix, (float*)(ws + WS_VST + (size_t)a * MiB), lds}; pg8::gemm_phase<pg8::EpiGeluStats, true>(lds, g, S, E);
        } else if ((s == 0 && kind == 1) || s == 5) {
            const bool ffn = s == 5; const int N = ffn ? 2 * FH : 2048;
            pg8::Gemm g{XB, Wb + (ffn ? WO_F_GU0 + (size_t)L * WO_F_STRIDE : WO_B_CX), M, N, D, D, 0, 0u}; S.init(M, N, G, bidx);
            pg8::EpiPair E{ffn ? H : T1, ffn ? FH : D, ffn ? ss_ffn : ss_mix, ffn ? 1 : 0, ffn ? 0u : CHUNK_ADJ}; pg8::gemm_phase<pg8::EpiPair, true>(lds, g, S, E);
        } else if (s == 0 || s == 1 || s == 3) {
            const bool grp = s == 3;
            pg8::Gemm g{grp ? T2 : XB, Wb + (grp ? WO_C_GRP : s == 1 ? WO_B_B : WO_C_IN), M, D, grp ? 256 : D, D, grp ? 256 : 0, 0u}; S.init(M, D, G, bidx);
            pg8::EpiPlain E{s == 0 ? T1 : T1 + CHUNK_ADJ, D, grp ? nullptr : ss_mix, grp ? INP(14) : nullptr, CHUNK_ADJ}; pg8::gemm_phase<pg8::EpiPlain, true>(lds, g, S, E);
        } else {
            const bool dn = s == 6;
            const bf16_t* Am = dn ? H : kind == 2 ? T1 + CHUNK_ADJ : T2;
            const bf16_t* Wm = Wb + (dn ? WO_F_D0 + (size_t)L * WO_F_STRIDE : kind == 0 ? WO_A_OUT0 + (size_t)a * WO_A_STRIDE : kind == 1 ? WO_B_OUT : WO_C_OUT);
            pg8::Gemm g{Am, Wm, M, D, dn ? FH : D, dn ? FH : D, 0, (!dn && kind == 2) ? 2u * CHUNK_ADJ : 0u}; S.init(M, D, G, bidx);
            if (dn && L == DEPTH - 1 && teams) { pg8::EpiResFin E{XB, ss_next, OUTP, INP(3), (unsigned*)(ws + WS_BAR) + XL_PCNT, lds}; pg8::gemm_phase<pg8::EpiResFin, true>(lds, g, S, E); }
            else { pg8::EpiRes E{XB, dn ? ss_next : ss_ffn, lds}; pg8::gemm_phase<pg8::EpiRes, true>(lds, g, S, E); }
        }
    }
}

extern "C" void kernel_launch(void* const* d_in, const int* in_sizes, int n_in, void* d_out, int out_size, void* d_ws, size_t ws_size, hipStream_t stream) {
    static int grid = 0;
    if (grid == 0) {
        if (n_in != 19 || in_sizes[0] != M * D || out_size != M * D || ws_size < WS_END) { fprintf(stderr, "kernel_launch: unexpected shapes (n_in %d, in0 %d, out %d, ws %zu)\n", n_in, n_in > 0 ? in_sizes[0] : -1, out_size, ws_size); grid = -1; return; }
        int dev = 0, cus = 0, per_cu = 0;
        hipGetDevice(&dev); hipDeviceGetAttribute(&cus, hipDeviceAttributeMultiprocessorCount, dev);
        hipFuncSetAttribute((const void*)fwd_megakernel, hipFuncAttributeMaxDynamicSharedMemorySize, LDS_BYTES);
        hipOccupancyMaxActiveBlocksPerMultiprocessor(&per_cu, (const void*)fwd_megakernel, NTHR, LDS_BYTES);
        (void)hipGetLastError();
        if (per_cu < 1) per_cu = 1;
        grid = cus * 1; if (grid != 256) { fprintf(stderr, "kernel_launch: built for 256 CUs (8 XCDs x 32: the fused final norm needs 32-workgroup XCD teams); this device reports %d\n", grid); grid = -1; return; }
        fprintf(stderr, "kernel_launch: cus %d per_cu %d grid %d\n", cus, per_cu, grid);
    }
    if (grid < 0) return;
    hipMemsetAsync((char*)d_ws + WS_BAR, 0, BAR_BYTES, stream);
    Args a{};
    for (int i = 0; i < 19; ++i) a.in[i] = (const float*)d_in[i];
    a.out = (float*)d_out; a.ws = (unsigned char*)d_ws; a.ph_lo = 0; a.ph_hi = NPH;
    void* args[] = {&a};
    hipError_t e = hipLaunchCooperativeKernel((const void*)fwd_megakernel, dim3(grid), dim3(NTHR), args, LDS_BYTES, stream);
    if (e != hipSuccess) fprintf(stderr, "cooperative launch failed: %s (grid %d)\n", hipGetErrorString(e), grid);
}
```
